# Optimizing an MI355X kernel written in HIP

```python
import math
import jax, jax.numpy as jnp
from jax import lax
import numpy as np


D_MODEL = 1024
BATCH = 2
SEQ = 16384
DEPTH = 2

D_MIX = D_MODEL
HEAD_DIM = 64
W_A = D_MIX // 4
W_B = D_MIX // 4
W_C = D_MIX - W_A - W_B
N_HEADS_A = W_A // HEAD_DIM
N_Q_HEADS = W_C // HEAD_DIM
GQA_GROUP = 4
N_KV_HEADS = N_Q_HEADS // GQA_GROUP
KV_W = N_KV_HEADS * HEAD_DIM
CHUNK = 128
CONV_WIDTH = 31
CONV_PAD = CONV_WIDTH // 2
WINDOW = 128
BLOCK = 128
N_BUCKETS = 32
MAX_DISTANCE = 128
LN_EPS = 1e-5
NEG_INF = -1e30
DEEPNORM_ALPHA = (2 * DEPTH) ** 0.25
DEEPNORM_BETA = (8 * DEPTH) ** -0.25
SPLITS = (W_A, W_A, W_A,
          W_B, W_B, W_B,
          W_C, KV_W, KV_W, W_C)
D_IN = 3 * W_A + 3 * W_B + 2 * W_C + 2 * KV_W

kernel_name = 'hybrid_gmlp_conformer_swa_deepnorm'


def layer_norm(x, g, b):
    xf = x.astype(jnp.float32)
    mu = jnp.mean(xf, axis=-1, keepdims=True)
    var = jnp.mean(jnp.square(xf - mu), axis=-1, keepdims=True)
    y = (xf - mu) * lax.rsqrt(var + LN_EPS)
    return (y * g.astype(jnp.float32) + b.astype(jnp.float32)).astype(x.dtype)


def t5_bucket(rel):
    nb = N_BUCKETS // 2
    max_exact = nb // 2
    ret = jnp.where(rel > 0, nb, 0)
    n = jnp.abs(rel)
    nf = jnp.maximum(n, 1).astype(jnp.float32)
    large = max_exact + (jnp.log(nf / max_exact) / math.log(MAX_DISTANCE / max_exact)
                         * (nb - max_exact)).astype(jnp.int32)
    large = jnp.minimum(large, nb - 1)
    return ret + jnp.where(n < max_exact, n, large)


def band_geometry(seq):
    nblk = seq // BLOCK
    qq = jnp.arange(BLOCK)[:, None]
    kk = jnp.arange(3 * BLOCK)[None, :]
    rel = kk - BLOCK - qq
    in_window = jnp.abs(rel) <= WINDOW
    key_pos = jnp.arange(nblk)[:, None] * BLOCK - BLOCK + jnp.arange(3 * BLOCK)[None, :]
    valid = (key_pos >= 0) & (key_pos < seq)
    mask = in_window[None] & valid[:, None, :]
    return rel, mask


def mixer_spatial_gating(u, v, gate, ln_g, ln_b, w_s, b_s):
    bsz, seq, _ = u.shape
    u = jax.nn.gelu(u)
    v = layer_norm(jax.nn.gelu(v), ln_g, ln_b)
    v = v.reshape(bsz, seq // CHUNK, CHUNK, N_HEADS_A, HEAD_DIM)
    v = jnp.einsum('hij,bcjhd->bcihd', w_s, v) + b_s.T[None, None, :, :, None]
    return u * v.reshape(bsz, seq, W_A) * jax.nn.silu(gate)


def mixer_conformer_conv(a, b, gate, conv_w, conv_b, ln_g, ln_b):
    y = a * jax.nn.sigmoid(b)
    y = lax.conv_general_dilated(
        y, conv_w[:, None, :], window_strides=(1,), padding=[(CONV_PAD, CONV_PAD)],
        dimension_numbers=('NWC', 'WIO', 'NWC'), feature_group_count=W_B) + conv_b
    y = layer_norm(y, ln_g, ln_b)
    return jax.nn.silu(y) * jax.nn.silu(gate)


def mixer_window_attention(q, k, v, gate, sink, bias, mask):
    bsz, seq, _ = q.shape
    nblk = seq // BLOCK
    q = q.reshape(bsz, nblk, BLOCK, N_KV_HEADS, GQA_GROUP, HEAD_DIM)

    def band(t):
        t = t.reshape(bsz, seq, N_KV_HEADS, HEAD_DIM)
        t = jnp.pad(t, ((0, 0), (BLOCK, BLOCK), (0, 0), (0, 0)))
        t = t.reshape(bsz, nblk + 2, BLOCK, N_KV_HEADS, HEAD_DIM)
        return jnp.concatenate([t[:, :nblk], t[:, 1:nblk + 1], t[:, 2:]], axis=2)

    kb, vb = band(k), band(v)
    s = jnp.einsum('bnqkgd,bnskd->bnkgqs', q, kb).astype(jnp.float32) * (HEAD_DIM ** -0.5)
    s = jnp.where(mask[None, :, None, None], s + bias, NEG_INF)
    sk = sink.astype(jnp.float32).reshape(1, 1, N_KV_HEADS, GQA_GROUP, 1, 1)
    m = jnp.maximum(jnp.max(s, axis=-1, keepdims=True), sk)
    p = jnp.exp(s - m)
    p = p / (jnp.sum(p, axis=-1, keepdims=True) + jnp.exp(sk - m))
    o = jnp.einsum('bnkgqs,bnskd->bnqkgd', p.astype(vb.dtype), vb)
    return o.reshape(bsz, seq, W_C) * jax.nn.silu(gate)


def setup_inputs(seed: int = 0) -> dict:
    key = jax.random.key(seed)
    ks = jax.random.split(key, 20)
    f32 = jnp.float32
    nrm = lambda k, shape: jax.random.normal(k, shape, f32)
    return {
        'x': nrm(ks[0], (BATCH, SEQ, D_MODEL)),
        'ln_in_g': 1.0 + 0.05 * nrm(ks[1], (D_MODEL,)),
        'ln_in_b': 0.02 * nrm(ks[2], (D_MODEL,)),
        'w_in': nrm(ks[3], (DEPTH, D_MODEL, D_IN)) * D_MODEL ** -0.5,
        'gmlp_ln_g': 1.0 + 0.05 * nrm(ks[4], (DEPTH, W_A)),
        'gmlp_ln_b': 0.02 * nrm(ks[5], (DEPTH, W_A)),
        'w_spatial': nrm(ks[6], (DEPTH, N_HEADS_A, CHUNK, CHUNK)) * CHUNK ** -0.5,
        'b_spatial': 1.0 + 0.1 * nrm(ks[7], (DEPTH, N_HEADS_A, CHUNK)),
        'conv_w': nrm(ks[8], (DEPTH, CONV_WIDTH, W_B)) * CONV_WIDTH ** -0.5,
        'conv_b': 0.02 * nrm(ks[9], (DEPTH, W_B)),
        'conv_ln_g': 1.0 + 0.05 * nrm(ks[10], (DEPTH, W_B)),
        'conv_ln_b': 0.02 * nrm(ks[11], (DEPTH, W_B)),
        'attn_sink': 0.5 * nrm(ks[12], (DEPTH, N_Q_HEADS)),
        'rel_bias': 0.5 * nrm(ks[13], (N_BUCKETS, N_Q_HEADS)),
        'w_out': nrm(ks[14], (DEPTH, D_MIX, D_MODEL)) * (D_MIX ** -0.5) * DEEPNORM_BETA,
        'post_ln_g': 1.0 + 0.05 * nrm(ks[15], (DEPTH, D_MODEL)),
        'post_ln_b': 0.02 * nrm(ks[16], (DEPTH, D_MODEL)),
    }


def reference(x, ln_in_g, ln_in_b, w_in, gmlp_ln_g, gmlp_ln_b, w_spatial, b_spatial,
              conv_w, conv_b, conv_ln_g, conv_ln_b, attn_sink, rel_bias, w_out,
              post_ln_g, post_ln_b):
    seq = x.shape[1]
    split_points = np.cumsum(SPLITS)[:-1].tolist()
    rel, mask = band_geometry(seq)
    bias = rel_bias.astype(jnp.float32)[t5_bucket(rel)]
    bias = jnp.transpose(bias, (2, 0, 1)).reshape(N_KV_HEADS, GQA_GROUP, BLOCK, 3 * BLOCK)

    x = layer_norm(x, ln_in_g, ln_in_b)
    for l in range(DEPTH):
        h = jnp.einsum('bsd,de->bse', x, w_in[l])
        au, av, ag, ba, bb, bg, cq, ck, cv, cg = jnp.split(h, split_points, axis=-1)
        ya = mixer_spatial_gating(au, av, ag, gmlp_ln_g[l], gmlp_ln_b[l],
                                  w_spatial[l], b_spatial[l])
        yb = mixer_conformer_conv(ba, bb, bg, conv_w[l], conv_b[l],
                                  conv_ln_g[l], conv_ln_b[l])
        yc = mixer_window_attention(cq, ck, cv, cg, attn_sink[l], bias, mask)
        y = jnp.einsum('bse,ed->bsd', jnp.concatenate([ya, yb, yc], axis=-1), w_out[l])
        x = layer_norm(DEEPNORM_ALPHA * x + y, post_ln_g[l], post_ln_b[l])
    return x
```

```cpp
#include <hip/hip_runtime.h>
#include <hip/hip_cooperative_groups.h>
#include <cstdio>
#include <cstdint>
namespace cg = cooperative_groups;
namespace pg8 {
#define PG8_LAS __attribute__((address_space(3)))
typedef unsigned short bf16_t;
typedef short bf16x8 __attribute__((ext_vector_type(8)));
typedef float f32x4 __attribute__((ext_vector_type(4)));
typedef unsigned u32x4 __attribute__((ext_vector_type(4)));
constexpr int BM = 256, BK = 64, HALF = 128, HTB = HALF * BK * 2  , STAGE_BYTES = 8 * HTB, NXCD = 8, WGM = 8;

__host__ __device__ __forceinline__ int lds_byte(int r, int c) { const int st = (r >> 4) * 2 + (c >> 5), rr = r & 15, cc = c & 31, ob = rr * 64 + cc * 2; return st * 1024 + (ob ^ (((ob >> 9) & 1) << 5)); }
__host__ __device__ __forceinline__ void stage_rc(int b, int& R, int& C) { const int st = b / 1024, sb = b % 1024, swz = sb ^ (((sb >> 9) & 1) << 5); R = (st >> 1) * 16 + swz / 64; C = (st & 1) * 32 + (swz % 64) / 2; }
__host__ __device__ __forceinline__ int perm32(int rho) { const int n = rho >> 4, i = rho & 15; return 8 * (i >> 2) + 4 * n + (i & 3); }

struct Unit { int pm, pn; };
struct Gemm { const bf16_t* A; const bf16_t* Bt; int M, N, K; };

struct StaticOrder {
    int nM, nN, nwg, G, c;
    __host__ __device__ void init(int M, int N, int G_, int c_) { nM = M / BM; nN = N / BM; nwg = nM * nN; G = G_; c = c_; }
    __host__ __device__ bool next(int i, Unit& u) const {
        const long L = (long)i * G + c; if (L >= nwg) return false;
        int wgid = (int)L; { const int q = nwg / NXCD, r = nwg % NXCD, xcd = wgid % NXCD, off = wgid / NXCD; wgid = (xcd < r ? xcd * (q + 1) : r * (q + 1) + (xcd - r) * q) + off; }
        const int nig = WGM * nN, gid = wgid / nig, fm = gid * WGM, gsz = (nM - fm) < WGM ? (nM - fm) : WGM;
        u.pm = fm + ((wgid % nig) % gsz); u.pn = (wgid % nig) / gsz; return true;
    }
    __device__ __forceinline__ void a_ready(const Unit&) const {}
    __device__ __forceinline__ void done(const Unit&) const {}
};

__device__ __forceinline__ unsigned cvt_pk_bf16(float lo, float hi) { unsigned r; asm volatile("v_cvt_pk_bf16_f32 %0, %1, %2" : "=v"(r) : "v"(lo), "v"(hi)); return r; }
typedef float f32x2 __attribute__((ext_vector_type(2)));
__device__ __forceinline__ f32x2 gelu_pk(f32x2 v) {
    const f32x2 av = __builtin_elementwise_abs(v), d = av * 0.2316418882f + 1.0f;
    f32x2 t; t.x = __builtin_amdgcn_rcpf(d.x); t.y = __builtin_amdgcn_rcpf(d.y);
    f32x2 q = t * 0.5307027145f + (-0.7265760135f); q = q * t + 0.7107068705f; q = q * t + (-0.142248368f); q = q * t + 0.127414796f; q = q * t;
    const f32x2 s = (v * v) * (-0.72134752044f);
    f32x2 e; e.x = __builtin_amdgcn_exp2f(s.x); e.y = __builtin_amdgcn_exp2f(s.y);
    const f32x2 m = v * (q * e), r = v - m;
    f32x2 o; o.x = v.x < 0.f ? m.x : r.x; o.y = v.y < 0.f ? m.y : r.y; return o;
}

template <int ACT  > struct EpiBf16 {
    static constexpr bool PERM = true, AFTER_DRAIN = false; static_assert(ACT == 0 || ACT == 1, "EpiBf16: ACT is 0 (none) or 1 (gelu_pk)");
    bf16_t* O; int ldc; const float* bias; int split_cols; size_t split_stride; float scale0;
    __device__ __forceinline__ void operator()(const f32x4 (&acc)[2][2][4][2], const Unit& u, int wr, int wc, int fr, int fq) const {
        const int row0 = u.pm * BM + wr * 64 + fr; int colt = u.pn * BM; bf16_t* base = O;
        float sc = 1.f; if (split_cols) { const int t = colt / split_cols; base += (size_t)t * split_stride; colt -= t * split_cols; if (t == 0) sc = scale0; }
        const int col0 = colt + wc * 32 + 8 * fq, bcol0 = u.pn * BM + wc * 32 + 8 * fq;
        f32x4 bv[2][2];
#pragma unroll
        for (int bj = 0; bj < 2; ++bj)
#pragma unroll
            for (int n = 0; n < 2; ++n) bv[bj][n] = bias ? *(const f32x4*)(bias + bcol0 + bj * HALF + 4 * n) : (f32x4){0.f, 0.f, 0.f, 0.f};
#pragma unroll
        for (int ai = 0; ai < 2; ++ai)
#pragma unroll
            for (int m = 0; m < 4; ++m) { bf16_t* rowp = base + (size_t)(row0 + ai * HALF + m * 16) * ldc + col0;
#pragma unroll
                for (int bj = 0; bj < 2; ++bj) { f32x4 v0 = acc[ai][bj][m][0] + bv[bj][0], v1 = acc[ai][bj][m][1] + bv[bj][1];
                    if (ACT == 1) { f32x2 a = gelu_pk((f32x2){v0[0], v0[1]}), b = gelu_pk((f32x2){v0[2], v0[3]}), c = gelu_pk((f32x2){v1[0], v1[1]}), d = gelu_pk((f32x2){v1[2], v1[3]});
                        v0 = (f32x4){a.x, a.y, b.x, b.y}; v1 = (f32x4){c.x, c.y, d.x, d.y}; }
                    v0 = v0 * sc; v1 = v1 * sc; u32x4 w; w.x = cvt_pk_bf16(v0[0], v0[1]); w.y = cvt_pk_bf16(v0[2], v0[3]); w.z = cvt_pk_bf16(v1[0], v1[1]); w.w = cvt_pk_bf16(v1[2], v1[3]);
                    *(u32x4*)(rowp + bj * HALF) = w; } }
    }
};

struct PanelStats {
    unsigned* xbuf;
    unsigned* cnt;
    unsigned* tmo;
    int ntn; float eps;
    unsigned code;
    __device__ __forceinline__ bool run(const f32x4 (&v)[2][2][4][2], const Unit& u, int wr, int wc, int fr, int fq, PG8_LAS unsigned char* lds, int wid, int lane) const {
        typedef float f32x2v __attribute__((ext_vector_type(2)));
        PG8_LAS f32x2v* P = (PG8_LAS f32x2v*)lds;
        PG8_LAS f32x2v* S = (PG8_LAS f32x2v*)(lds + 8192);
        PG8_LAS unsigned* flag = (PG8_LAS unsigned*)(lds + 8192 + 2048);
#pragma unroll
        for (int ai = 0; ai < 2; ++ai)
#pragma unroll
            for (int m = 0; m < 4; ++m) {
                float s = 0.f;
#pragma unroll
                for (int bj = 0; bj < 2; ++bj)
#pragma unroll
                    for (int n = 0; n < 2; ++n) { const f32x4 x = v[ai][bj][m][n]; s += (x[0] + x[1]) + (x[2] + x[3]); }
                s += __shfl_xor(s, 16); s += __shfl_xor(s, 32);
                const float mw = s * (1.0f / 64.0f); float q = 0.f;
#pragma unroll
                for (int bj = 0; bj < 2; ++bj)
#pragma unroll
                    for (int n = 0; n < 2; ++n) { const f32x4 d = v[ai][bj][m][n] - mw; q += (d[0] * d[0] + d[1] * d[1]) + (d[2] * d[2] + d[3] * d[3]); }
                q += __shfl_xor(q, 16); q += __shfl_xor(q, 32);
                if (fq == 0) P[(ai * HALF + wr * 64 + m * 16 + fr) * 4 + wc] = (f32x2v){mw, q};
            }
        asm volatile("s_waitcnt lgkmcnt(0)" ::: "memory"); __builtin_amdgcn_s_barrier(); asm volatile("" ::: "memory");
#if defined(BROKEN_EXCHANGE_NO_WAIT)
#warning BROKEN CONTROL BUILD: the row-statistics exchange does not wait; results are wrong by design
        if (blockIdx.x >= 64) { const long long t0_ = clock64(); while (clock64() - t0_ < 60000) __builtin_amdgcn_s_sleep(8); }
#endif
        const int row = wid * 32 + (lane & 31);
        if (lane < 32) {
            const f32x2v a = P[row * 4 + 0], b = P[row * 4 + 1], c = P[row * 4 + 2], d = P[row * 4 + 3];
            const float mt = (a.x + b.x + c.x + d.x) * 0.25f;
            const float da = a.x - mt, db = b.x - mt, dc = c.x - mt, dd = d.x - mt;
            const float m2 = (a.y + b.y) + (c.y + d.y) + 64.0f * ((da * da + db * db) + (dc * dc + dd * dd));
            unsigned long long* slot = (unsigned long long*)xbuf + ((size_t)(u.pm * BM + row) * 4 + u.pn);
            __hip_atomic_store(slot, ((unsigned long long)__float_as_uint(m2) << 32) | __float_as_uint(mt), __ATOMIC_RELAXED, __HIP_MEMORY_SCOPE_AGENT);
        }
        asm volatile("s_waitcnt vmcnt(0)" ::: "memory");
        if (lane == 0) __hip_atomic_fetch_add(cnt + 64 * u.pm, 1u, __ATOMIC_RELAXED, __HIP_MEMORY_SCOPE_AGENT);
        if (wid == 0) {
            bool dead = false; const unsigned long long t0 = __builtin_amdgcn_s_memrealtime(); const unsigned want = 8u * (unsigned)ntn;
            for (;;) {
#if defined(BROKEN_EXCHANGE_NO_WAIT)
                break;
#endif
                if ((unsigned)__builtin_amdgcn_readfirstlane(__hip_atomic_load(cnt + 64 * u.pm, __ATOMIC_RELAXED, __HIP_MEMORY_SCOPE_AGENT)) >= want) break;
                if (__builtin_amdgcn_s_memrealtime() - t0 > 2000000ull) {
                    if (lane == 0) { unsigned expect = 0u; __hip_atomic_compare_exchange_strong(tmo + 1, &expect, code | (unsigned)(u.pm & 0xff), __ATOMIC_RELAXED, __ATOMIC_RELAXED, __HIP_MEMORY_SCOPE_AGENT);
                                     __hip_atomic_store(tmo, 1u, __ATOMIC_RELAXED, __HIP_MEMORY_SCOPE_AGENT); }
                    dead = true; break; }
                __builtin_amdgcn_s_sleep(2);
            }
            __builtin_amdgcn_fence(__ATOMIC_ACQUIRE, "agent");
            if (lane == 0) flag[0] = dead ? 1u : 0u;
        }
        asm volatile("s_waitcnt vmcnt(0) lgkmcnt(0)" ::: "memory"); __builtin_amdgcn_s_barrier(); asm volatile("" ::: "memory");
        const bool bad = flag[0] != 0u;
        if (lane < 32) {
            const unsigned long long* slot = (const unsigned long long*)xbuf + (size_t)(u.pm * BM + row) * 4; float mt[4], m2[4]; float ms = 0.f;
#pragma unroll
            for (int t = 0; t < 4; ++t) { if (t < ntn) { const unsigned long long w = __hip_atomic_load(slot + t, __ATOMIC_RELAXED, __HIP_MEMORY_SCOPE_AGENT); mt[t] = __uint_as_float((unsigned)w); m2[t] = __uint_as_float((unsigned)(w >> 32)); } else { mt[t] = 0.f; m2[t] = 0.f; } ms += mt[t]; }
            const float mean = ms / (float)ntn; float q = 0.f;
#pragma unroll
            for (int t = 0; t < 4; ++t) if (t < ntn) { const float dm = mt[t] - mean; q += m2[t] + 256.0f * dm * dm; }
            S[row] = (f32x2v){mean, 1.0f / sqrtf(q / (256.0f * (float)ntn) + eps)};
        }
        asm volatile("s_waitcnt lgkmcnt(0)" ::: "memory"); __builtin_amdgcn_s_barrier(); asm volatile("" ::: "memory");
        return bad;
    }
};
struct EpiLnRes {
    static constexpr bool PERM = false, AFTER_DRAIN = true;
    const float* base; float* out; int ldc; const float* bias; PanelStats st; unsigned poison;
    __device__ __forceinline__ void fused(f32x4 (&acc)[2][2][4][2], const Unit& u, int wr, int wc, int fr, int fq, PG8_LAS unsigned char* lds, int wid, int lane) const {
        typedef float f32x2v __attribute__((ext_vector_type(2)));
        const PG8_LAS f32x2v* S = (const PG8_LAS f32x2v*)(lds + 8192);
        const int col0 = u.pn * BM + wc * 32 + 4 * fq;
#pragma unroll
        for (int bj = 0; bj < 2; ++bj)
#pragma unroll
            for (int n = 0; n < 2; ++n) { const f32x4 bv = bias ? *(const f32x4*)(bias + col0 + bj * HALF + n * 16) : (f32x4){0.f, 0.f, 0.f, 0.f};
#pragma unroll
                for (int ai = 0; ai < 2; ++ai)
#pragma unroll
                    for (int m = 0; m < 4; ++m) acc[ai][bj][m][n] += bv; }
        f32x4 pre[4][2][2];
#pragma unroll
        for (int m = 0; m < 4; ++m) { const size_t off = (size_t)(u.pm * BM + wr * 64 + m * 16 + fr) * ldc + col0;
#pragma unroll
            for (int bj = 0; bj < 2; ++bj)
#pragma unroll
                for (int n = 0; n < 2; ++n) pre[m][bj][n] = *(const f32x4*)(base + off + bj * HALF + n * 16); }
        const bool bad = st.run(acc, u, wr, wc, fr, fq, lds, wid, lane) || poison != 0u;
        const float qnan = __builtin_nanf("");
#pragma unroll
        for (int ai = 0; ai < 2; ++ai)
#pragma unroll
            for (int m = 0; m < 4; ++m) { const int r = ai * HALF + wr * 64 + m * 16 + fr; const f32x2v sr = S[r]; const size_t off = (size_t)(u.pm * BM + r) * ldc + col0;
#pragma unroll
                for (int bj = 0; bj < 2; ++bj)
#pragma unroll
                    for (int n = 0; n < 2; ++n) { const f32x4 bs = ai == 0 ? pre[m][bj][n] : *(const f32x4*)(base + off + bj * HALF + n * 16); f32x4 o = bs + (acc[ai][bj][m][n] - sr.x) * sr.y;
                        if (bad) o = (f32x4){qnan, qnan, qnan, qnan}; *(f32x4*)(out + off + bj * HALF + n * 16) = o; }
                if (m & 1) asm volatile("" ::: "memory"); }
    }
};
struct EpiLnResLn {
    static constexpr bool PERM = false, AFTER_DRAIN = true;
    const float* base; float* out; bf16_t* xn; int ldc; const float* bias; PanelStats st1, st2; unsigned poison;
    __device__ __forceinline__ void fused(f32x4 (&acc)[2][2][4][2], const Unit& u, int wr, int wc, int fr, int fq, PG8_LAS unsigned char* lds, int wid, int lane) const {
        typedef float f32x2v __attribute__((ext_vector_type(2))); typedef unsigned u32x2v __attribute__((ext_vector_type(2)));
        const PG8_LAS f32x2v* S = (const PG8_LAS f32x2v*)(lds + 8192);
        const int col0 = u.pn * BM + wc * 32 + 4 * fq;
#pragma unroll
        for (int bj = 0; bj < 2; ++bj)
#pragma unroll
            for (int n = 0; n < 2; ++n) { const f32x4 bv = bias ? *(const f32x4*)(bias + col0 + bj * HALF + n * 16) : (f32x4){0.f, 0.f, 0.f, 0.f};
#pragma unroll
                for (int ai = 0; ai < 2; ++ai)
#pragma unroll
                    for (int m = 0; m < 4; ++m) acc[ai][bj][m][n] += bv; }
        bool bad = st1.run(acc, u, wr, wc, fr, fq, lds, wid, lane) || poison != 0u;
        const float qnan = __builtin_nanf("");
#pragma unroll
        for (int ai = 0; ai < 2; ++ai)
#pragma unroll
            for (int m = 0; m < 4; ++m) { const int r = ai * HALF + wr * 64 + m * 16 + fr; const f32x2v sr = S[r]; const size_t off = (size_t)(u.pm * BM + r) * ldc + col0;
#pragma unroll
                for (int bj = 0; bj < 2; ++bj)
#pragma unroll
                    for (int n = 0; n < 2; ++n) { const f32x4 bs = *(const f32x4*)(base + off + bj * HALF + n * 16); acc[ai][bj][m][n] = bs + (acc[ai][bj][m][n] - sr.x) * sr.y; }
                asm volatile("" : "+v"(acc[ai][0][m][0]), "+v"(acc[ai][0][m][1]), "+v"(acc[ai][1][m][0]), "+v"(acc[ai][1][m][1]));
                if (m & 1) asm volatile("" ::: "memory"); }
        const bool bad1 = bad;
        bad = st2.run(acc, u, wr, wc, fr, fq, lds, wid, lane) || bad;
#pragma unroll
        for (int ai = 0; ai < 2; ++ai)
#pragma unroll
            for (int m = 0; m < 4; ++m) { const int r = ai * HALF + wr * 64 + m * 16 + fr; const f32x2v sr = S[r]; const size_t off = (size_t)(u.pm * BM + r) * ldc + col0;
#pragma unroll
                for (int bj = 0; bj < 2; ++bj)
#pragma unroll
                    for (int n = 0; n < 2; ++n) { const f32x4 x1 = acc[ai][bj][m][n]; *(f32x4*)(out + off + bj * HALF + n * 16) = bad1 ? (f32x4){qnan, qnan, qnan, qnan} : x1;
                        const f32x4 o = (x1 - sr.x) * sr.y; u32x2v w; w.x = cvt_pk_bf16(o[0], o[1]); w.y = cvt_pk_bf16(o[2], o[3]);
                        if (bad) { w.x = 0x7fc07fc0u; w.y = 0x7fc07fc0u; } *(u32x2v*)(xn + off + bj * HALF + n * 16) = w; }
                asm volatile("" ::: "memory"); }
    }
};

template <class Epi, class Sched, bool ALIGN_EPI = false, bool SP2 = false>
__device__ __forceinline__ void gemm_phase(PG8_LAS unsigned char* lds, const Gemm g, const Sched& S, const Epi& E) {
    int tid_ = threadIdx.x; asm volatile("" : "+v"(tid_));
    const int tid = tid_, wid = __builtin_amdgcn_readfirstlane(tid >> 6), lane = tid & 63, wr = wid >> 2, wc = wid & 3, fr = lane & 15, fq = lane >> 4;
    const int K = g.K, nt = K / BK;
    unsigned voffA[2], voffB[2];
#pragma unroll
    for (int i = 0; i < 2; ++i) { int R, C; stage_rc(tid * 16 + i * 8192, R, C); const int Rb = Epi::PERM ? ((R & ~31) + perm32(R & 31)) : R;
        voffA[i] = (unsigned)(R * K + C) * 2u; voffB[i] = (unsigned)(Rb * K + C) * 2u; }
    const size_t kstep = (size_t)(BK * 2);
    const size_t hstep = (size_t)HALF * K * 2;
    const size_t tstep = 2 * hstep;
    const unsigned ldsw = (unsigned)wid * 1024u;
    const int aoff = lds_byte(wr * 64 + fr, fq * 8), boff = lds_byte(wc * 32 + fr, fq * 8);
#define PG8_SA(b, h) (((b) * 2 + (h)) * HTB)
#define PG8_SB(b, h) ((4 + (b) * 2 + (h)) * HTB)
#define PG8_STAGE(bufoff, gbase, voff) do { _Pragma("unroll") for (int _i = 0; _i < 2; ++_i) \
        __builtin_amdgcn_global_load_lds((const unsigned*)((const char*)(gbase) + (voff)[_i]), (PG8_LAS unsigned*)(lds + (bufoff) + ldsw + _i * 8192), 16, 0, 0); } while (0)
#define PG8_LDA(dst, b, h) do { _Pragma("unroll") for (int m = 0; m < 4; ++m) _Pragma("unroll") for (int k = 0; k < 2; ++k) dst[m][k] = *(const PG8_LAS bf16x8*)(lds + PG8_SA(b, h) + aoff + m * 2048 + k * 1024); } while (0)
#define PG8_LDB(dst, b, h) do { _Pragma("unroll") for (int n = 0; n < 2; ++n) _Pragma("unroll") for (int k = 0; k < 2; ++k) dst[n][k] = *(const PG8_LAS bf16x8*)(lds + PG8_SB(b, h) + boff + n * 2048 + k * 1024); } while (0)
#define PG8_MMA(ai, bj, At, Bt) do { __builtin_amdgcn_s_setprio(1); _Pragma("unroll") for (int m = 0; m < 4; ++m) _Pragma("unroll") for (int n = 0; n < 2; ++n) _Pragma("unroll") for (int k = 0; k < 2; ++k) \
        acc[ai][bj][m][n] = __builtin_amdgcn_mfma_f32_16x16x32_bf16(Bt[n][k], At[m][k], acc[ai][bj][m][n], 0, 0, 0); __builtin_amdgcn_s_setprio(0); } while (0)
#define PG8_WAIT_V(n) asm volatile("s_waitcnt vmcnt(" #n ")" ::: "memory")
#define PG8_WAIT_L(n) asm volatile("s_waitcnt lgkmcnt(" #n ")" ::: "memory")
#define PG8_BAR __builtin_amdgcn_s_barrier()
#define PG8_SCHED __builtin_amdgcn_sched_barrier(0)
    Unit cur, nxt; int ui = 0;
    if (!S.next(0, cur)) return;
    f32x4 acc[2][2][4][2];
#pragma unroll
    for (int a = 0; a < 2; ++a)
#pragma unroll
        for (int b = 0; b < 2; ++b)
#pragma unroll
            for (int m = 0; m < 4; ++m)
#pragma unroll
                for (int n = 0; n < 2; ++n) acc[a][b][m][n] = (f32x4){0.f, 0.f, 0.f, 0.f};
    bf16x8 At[4][2], B0[2][2], B1[2][2];
    const char* cA = (const char*)g.A + (size_t)cur.pm * tstep; const char* cB = (const char*)g.Bt + (size_t)cur.pn * tstep;
    S.a_ready(cur);
    if constexpr (SP2) {
        PG8_STAGE(PG8_SB(0, 0), cB, voffB); PG8_STAGE(PG8_SB(0, 1), cB + hstep, voffB); PG8_STAGE(PG8_SA(0, 0), cA, voffA); PG8_STAGE(PG8_SA(0, 1), cA + hstep, voffA);
        if (wr == 1) PG8_BAR;
        PG8_WAIT_V(2); PG8_BAR;
        PG8_STAGE(PG8_SB(1, 0), cB + kstep, voffB); PG8_STAGE(PG8_SA(1, 0), cA + kstep, voffA); PG8_STAGE(PG8_SB(1, 1), cB + hstep + kstep, voffB);
        PG8_WAIT_V(6); PG8_BAR;
    } else {
        PG8_STAGE(PG8_SB(0, 0), cB, voffB); PG8_STAGE(PG8_SA(0, 0), cA, voffA); PG8_STAGE(PG8_SB(0, 1), cB + hstep, voffB); PG8_STAGE(PG8_SA(0, 1), cA + hstep, voffA);
        if (wr == 1) PG8_BAR;
        PG8_WAIT_V(4); PG8_BAR;
        PG8_STAGE(PG8_SB(1, 0), cB + kstep, voffB); PG8_STAGE(PG8_SA(1, 0), cA + kstep, voffA); PG8_STAGE(PG8_SB(1, 1), cB + hstep + kstep, voffB);
        PG8_WAIT_V(6); PG8_BAR;
    }
    for (;;) {
        const bool has_next = S.next(ui + 1, nxt);
        const char* nA = has_next ? (const char*)g.A + (size_t)nxt.pm * tstep : cA; const char* nB = has_next ? (const char*)g.Bt + (size_t)nxt.pn * tstep : cB;
        for (int t = 0; t < nt; t += 2) {
            const bool last = (t == nt - 2);
            const char* a1 = cA + (size_t)(t + 1) * kstep;
            const char* a2 = last ? nA : cA + (size_t)(t + 2) * kstep; const char* b2 = last ? nB : cB + (size_t)(t + 2) * kstep;
            const char* a3 = a2 + kstep; const char* b3 = b2 + kstep;
            if (last && has_next) S.a_ready(nxt);
            if constexpr (SP2) {
            PG8_LDB(B0, 0, 0); PG8_LDB(B1, 0, 1); PG8_SCHED; PG8_LDA(At, 0, 0); PG8_STAGE(PG8_SA(1, 1), a1 + hstep, voffA);
            PG8_WAIT_V(8); PG8_WAIT_L(0); PG8_BAR; PG8_MMA(0, 0, At, B0); PG8_MMA(0, 1, At, B1); PG8_BAR; PG8_SCHED;
            PG8_LDA(At, 0, 1); PG8_STAGE(PG8_SB(0, 0), b2, voffB); PG8_STAGE(PG8_SB(0, 1), b2 + hstep, voffB); PG8_STAGE(PG8_SA(0, 0), a2, voffA);
            PG8_WAIT_V(8); PG8_WAIT_L(0); PG8_BAR; PG8_MMA(1, 0, At, B0); PG8_MMA(1, 1, At, B1); PG8_BAR; PG8_SCHED;
            PG8_LDB(B0, 1, 0); PG8_LDB(B1, 1, 1); PG8_SCHED; PG8_LDA(At, 1, 0); PG8_STAGE(PG8_SA(0, 1), a2 + hstep, voffA);
            PG8_WAIT_V(8); PG8_WAIT_L(0); PG8_BAR; PG8_MMA(0, 0, At, B0); PG8_MMA(0, 1, At, B1); PG8_BAR; PG8_SCHED;
            PG8_LDA(At, 1, 1); PG8_STAGE(PG8_SB(1, 0), b3, voffB); PG8_STAGE(PG8_SB(1, 1), b3 + hstep, voffB); PG8_STAGE(PG8_SA(1, 0), a3, voffA);
            PG8_WAIT_V(8); PG8_WAIT_L(0); PG8_BAR; PG8_MMA(1, 0, At, B0); PG8_MMA(1, 1, At, B1); PG8_BAR; PG8_SCHED;
            } else {
            PG8_LDB(B0, 0, 0); PG8_SCHED; PG8_LDA(At, 0, 0); PG8_STAGE(PG8_SA(1, 1), a1 + hstep, voffA);
            PG8_WAIT_L(8); PG8_BAR; PG8_WAIT_L(0); PG8_MMA(0, 0, At, B0); PG8_BAR; PG8_SCHED;
            PG8_LDB(B1, 0, 1); PG8_STAGE(PG8_SB(0, 0), b2, voffB);
            PG8_BAR; PG8_WAIT_L(0); PG8_MMA(0, 1, At, B1); PG8_BAR;
            PG8_LDA(At, 0, 1); PG8_STAGE(PG8_SA(0, 0), a2, voffA);
            PG8_BAR; PG8_WAIT_L(0); PG8_MMA(1, 0, At, B0); PG8_BAR; PG8_SCHED;
            PG8_STAGE(PG8_SB(0, 1), b2 + hstep, voffB);
            PG8_WAIT_V(6); PG8_BAR; PG8_MMA(1, 1, At, B1); PG8_BAR;
            PG8_LDB(B0, 1, 0); PG8_SCHED; PG8_LDA(At, 1, 0); PG8_STAGE(PG8_SA(0, 1), a2 + hstep, voffA);
            PG8_WAIT_L(8); PG8_BAR; PG8_WAIT_L(0); PG8_MMA(0, 0, At, B0); PG8_BAR; PG8_SCHED;
            PG8_LDB(B1, 1, 1); PG8_STAGE(PG8_SB(1, 0), b3, voffB);
            PG8_BAR; PG8_WAIT_L(0); PG8_MMA(0, 1, At, B1); PG8_BAR;
            PG8_LDA(At, 1, 1); PG8_STAGE(PG8_SA(1, 0), a3, voffA);
            PG8_BAR; PG8_WAIT_L(0); PG8_MMA(1, 0, At, B0); PG8_BAR; PG8_SCHED;
            PG8_STAGE(PG8_SB(1, 1), b3 + hstep, voffB);
            PG8_WAIT_V(6); PG8_BAR; PG8_MMA(1, 1, At, B1); PG8_BAR;
            }
        }
        if constexpr (ALIGN_EPI) { if (wr == 0) PG8_BAR; }
        if constexpr (!Epi::AFTER_DRAIN) { E(acc, cur, wr, wc, fr, fq); S.done(cur); }
        if (!has_next) break;
#pragma unroll
        for (int a = 0; a < 2; ++a)
#pragma unroll
            for (int b = 0; b < 2; ++b)
#pragma unroll
                for (int m = 0; m < 4; ++m)
#pragma unroll
                    for (int n = 0; n < 2; ++n) acc[a][b][m][n] = (f32x4){0.f, 0.f, 0.f, 0.f};
        cur = nxt; cA = nA; cB = nB; ++ui;
        if constexpr (ALIGN_EPI) { if (wr == 1) PG8_BAR; }
    }
    PG8_WAIT_V(0);
    if constexpr (!ALIGN_EPI) { if (wr == 0) PG8_BAR; }
    PG8_BAR;
    if constexpr (Epi::AFTER_DRAIN) { E.fused(acc, cur, wr, wc, fr, fq, lds, wid, lane); S.done(cur); }
#undef PG8_SA
#undef PG8_SB
#undef PG8_STAGE
#undef PG8_LDA
#undef PG8_LDB
#undef PG8_MMA
#undef PG8_WAIT_V
#undef PG8_WAIT_L
#undef PG8_BAR
#undef PG8_SCHED
}
}

namespace pg8 {
struct EpiResF32 {
    static constexpr bool PERM = false, AFTER_DRAIN = false;
    const float* base; float* out; int ldc; float alpha;
    __device__ __forceinline__ void operator()(const f32x4 (&acc)[2][2][4][2], const Unit& u, int wr, int wc, int fr, int fq) const {
        const int row0 = u.pm * BM + wr * 64 + fr, col0 = u.pn * BM + wc * 32 + 4 * fq;
#pragma unroll
        for (int ai = 0; ai < 2; ++ai)
#pragma unroll
            for (int m = 0; m < 4; ++m) { const size_t off = (size_t)(row0 + ai * HALF + m * 16) * ldc + col0;
#pragma unroll
                for (int bj = 0; bj < 2; ++bj)
#pragma unroll
                    for (int n = 0; n < 2; ++n) { const f32x4 bs = *(const f32x4*)(base + off + bj * HALF + n * 16);
                        *(f32x4*)(out + off + bj * HALF + n * 16) = bs * alpha + acc[ai][bj][m][n]; } }
    }
};
}

constexpr int BATCH = 2, SEQ = 16384, DM = 1024, M = BATCH * SEQ, DIN = 2816, DEPTH = 2;
constexpr int CHUNK = 128, NCHUNK = M / CHUNK, CPS = SEQ / CHUNK;
constexpr int C_AU = 0, C_AV = 256, C_AG = 512, C_BA = 768, C_BB = 1024, C_BG = 1280, C_Q = 1536, C_K = 2048, C_V = 2176, C_CG = 2304;
constexpr float LN_EPS = 1e-5f;
constexpr float ALPHA = 1.4142135623730951f;
constexpr int NWAVES = 8, NT = 512;
constexpr int LDS_BYTES = 147456;
constexpr size_t MiB = 1u << 20;
constexpr size_t WS_WIN = 0;
constexpr size_t WS_WOUT = 12 * MiB;
constexpr size_t WS_BIAS = 17 * MiB;
constexpr size_t WS_XN = 32 * MiB;
constexpr size_t WS_H = 96 * MiB;
constexpr size_t WS_MIX = 272 * MiB;
constexpr size_t WS_END = 336 * MiB;
constexpr size_t WS_PAR = 18 * MiB;
constexpr int P_GMLP_G = 0, P_GMLP_B = 512, P_BSP = 1024, P_CONVB = 2048, P_CONVG = 2560, P_CONVBB = 3072, P_SINK = 3584, P_POSTG = 4096, P_POSTB = 6144, P_CONVW = 8192, P_WSP = 24576, P_END = 24576 + 131072;

typedef unsigned short bf16;
typedef float f32x4 __attribute__((ext_vector_type(4)));
typedef unsigned v4u __attribute__((ext_vector_type(4)));
#define LAS __attribute__((address_space(3)))

__device__ __forceinline__ float bf2f(unsigned short b) { return __uint_as_float((unsigned)b << 16); }
__device__ __forceinline__ float bflo(unsigned w) { return __uint_as_float(w << 16); }
__device__ __forceinline__ float bfhi(unsigned w) { return __uint_as_float(w & 0xffff0000u); }
__device__ __forceinline__ unsigned f2bf(float f) { unsigned u = __float_as_uint(f); return (u + 0x7fffu + ((u >> 16) & 1u)) >> 16; }
__device__ __forceinline__ unsigned pk2(float lo, float hi) { return f2bf(lo) | (f2bf(hi) << 16); }
__device__ __forceinline__ float sigmoid_f(float x) { return 1.f / (1.f + __expf(-x)); }
__device__ __forceinline__ float silu_f(float x) { return x / (1.f + __expf(-x)); }
__device__ __forceinline__ float gelu_f(float x) { const float u = 0.7978845608028654f * (x + 0.044715f * x * x * x); return x / (1.f + __expf(-2.f * u)); }
__device__ __forceinline__ float wave_sum(float v) {
#pragma unroll
    for (int o = 1; o < 64; o <<= 1) v += __shfl_xor(v, o);
    return v;
}
__device__ __forceinline__ int t5_bucket(int rel) {
    const int n = rel < 0 ? -rel : rel;
    const int b = n < 8 ? n : n < 12 ? 8 : n < 16 ? 9 : n < 23 ? 10 : n < 32 ? 11 : n < 46 ? 12 : n < 64 ? 13 : n < 91 ? 14 : 15;
    return b + (rel > 0 ? 16 : 0);
}

struct Args { const float* in[17]; float* out; unsigned char* ws; };

struct Ctx {
    int tid, lane, wave, G, bid;
    unsigned char* ws; float* out;
    __device__ __forceinline__ bf16* WIN() const { return (bf16*)(ws + WS_WIN); }
    __device__ __forceinline__ bf16* WOUT() const { return (bf16*)(ws + WS_WOUT); }
    __device__ __forceinline__ bf16* XN() const { return (bf16*)(ws + WS_XN); }
    __device__ __forceinline__ bf16* H() const { return (bf16*)(ws + WS_H); }
    __device__ __forceinline__ bf16* MIX() const { return (bf16*)(ws + WS_MIX); }
    __device__ __forceinline__ float* BIAS() const { return (float*)(ws + WS_BIAS); }
    __device__ __forceinline__ const float* P(int off) const { return (const float*)(ws + WS_PAR) + off; }
};

__device__ __forceinline__ Ctx fresh(const Ctx& F) {
    Ctx C = F; asm volatile("" : "+v"(C.tid)); C.lane = C.tid & 63; C.wave = __builtin_amdgcn_readfirstlane(C.tid >> 6);
    asm volatile("" : "+s"(C.ws), "+s"(C.out), "+s"(C.bid), "+s"(C.G)); return C;
}
__device__ __forceinline__ void p0_transpose_item(const float* W, int K, int N, bf16* WT, LAS float* scr, int item, int lane) {
    const int nblk = N / 32, kb = item / nblk, nb = item % nblk, k0 = 64 * kb, n0 = 32 * nb;
#pragma unroll 8
    for (int i = 0; i < 32; ++i) { const int kk = 2 * i + (lane >> 5); scr[kk * 33 + (lane & 31)] = W[(size_t)(k0 + kk) * N + n0 + (lane & 31)]; }
    asm volatile("s_waitcnt lgkmcnt(0)" ::: "memory");
    const int c = lane & 7;
#pragma unroll
    for (int j = 0; j < 4; ++j) { const int n = (lane >> 3) + 8 * j; const LAS float* s = scr + (8 * c) * 33 + n;
        v4u o; o.x = pk2(s[0 * 33], s[1 * 33]); o.y = pk2(s[2 * 33], s[3 * 33]); o.z = pk2(s[4 * 33], s[5 * 33]); o.w = pk2(s[6 * 33], s[7 * 33]);
        *(v4u*)(WT + (size_t)(n0 + n) * K + k0 + 8 * c) = o; }
    asm volatile("s_waitcnt lgkmcnt(0)" ::: "memory");
}
__device__ __forceinline__ void ln_row(const float* xrow, const float* g, const float* b, float* orow, bf16* brow, int lane) {
    const f32x4* xr = (const f32x4*)xrow + lane;
    f32x4 v[4]; float s = 0.f;
#pragma unroll
    for (int j = 0; j < 4; ++j) { v[j] = xr[64 * j]; s += (v[j].x + v[j].y) + (v[j].z + v[j].w); }
    const float mean = wave_sum(s) * (1.f / DM); float s2 = 0.f;
#pragma unroll
    for (int j = 0; j < 4; ++j) { v[j] = v[j] - mean; s2 += (v[j].x * v[j].x + v[j].y * v[j].y) + (v[j].z * v[j].z + v[j].w * v[j].w); }
    const float rstd = 1.f / sqrtf(wave_sum(s2) * (1.f / DM) + LN_EPS);
    f32x4* o4 = (f32x4*)orow + lane; unsigned long long* o8 = (unsigned long long*)brow + lane;
#pragma unroll
    for (int j = 0; j < 4; ++j) { const f32x4 gg = ((const f32x4*)g)[lane + 64 * j], bb = ((const f32x4*)b)[lane + 64 * j];
        const f32x4 y = v[j] * rstd * gg + bb; o4[64 * j] = y;
        o8[64 * j] = (unsigned long long)pk2(y.x, y.y) | ((unsigned long long)pk2(y.z, y.w) << 32); }
}
__device__ __forceinline__ void prologue(const Ctx& F, const Args& A, unsigned char* lds) {
    LAS float* scr = (LAS float*)((LAS unsigned char*)lds + F.wave * 16384);
    const int gw = F.bid * NWAVES + F.wave, NGW = F.G * NWAVES;
    constexpr int I_IN = (DM / 64) * (DIN / 32), I_OUT = (DM / 64) * (DM / 32);
    constexpr int NITEMS = DEPTH * (I_IN + I_OUT);
    for (int it = gw; it < NITEMS; it += NGW) {
        int r = it; const int l = r / (I_IN + I_OUT); r -= l * (I_IN + I_OUT);
        if (r < I_IN) p0_transpose_item(A.in[3] + (size_t)l * DM * DIN, DM, DIN, F.WIN() + (size_t)l * DIN * DM, scr, r, F.lane);
        else p0_transpose_item(A.in[14] + (size_t)l * DM * DM, DM, DM, F.WOUT() + (size_t)l * DM * DM, scr, r - I_IN, F.lane);
    }
    for (int m = gw; m < M; m += NGW) ln_row(A.in[0] + (size_t)m * DM, A.in[1], A.in[2], F.out + (size_t)m * DM, F.XN() + (size_t)m * DM, F.lane);
    if (F.bid == 0) for (int i = F.tid; i < 8 * 257; i += NT) { const int h = i / 257, rel = i % 257 - 128; F.BIAS()[i] = A.in[13][t5_bucket(rel) * 8 + h]; }
    {
        float* P = (float*)(F.ws + WS_PAR); const int gt = F.bid * NT + F.tid, GT = F.G * NT;
        for (int i = gt; i < 512; i += GT) { P[P_GMLP_G + i] = A.in[4][i]; P[P_GMLP_B + i] = A.in[5][i]; P[P_CONVB + i] = A.in[9][i]; P[P_CONVG + i] = A.in[10][i]; P[P_CONVBB + i] = A.in[11][i]; }
        for (int i = gt; i < 1024; i += GT) P[P_BSP + i] = A.in[7][i];
        for (int i = gt; i < 16; i += GT) P[P_SINK + i] = A.in[12][i];
        for (int i = gt; i < 2048; i += GT) { P[P_POSTG + i] = A.in[15][i]; P[P_POSTB + i] = A.in[16][i]; }
        for (int i = gt; i < 2 * 31 * 256; i += GT) P[P_CONVW + i] = A.in[8][i];
        for (int i = gt; i < 2 * 4 * 128 * 128; i += GT) P[P_WSP + i] = A.in[6][i];
    }
}
__device__ __forceinline__ void post_ln(const Ctx& F, int l) {
    const int gw = F.bid * NWAVES + F.wave, NGW = F.G * NWAVES;
    for (int m = gw; m < M; m += NGW) ln_row(F.out + (size_t)m * DM, F.P(P_POSTG) + l * DM, F.P(P_POSTB) + l * DM, F.out + (size_t)m * DM, F.XN() + (size_t)m * DM, F.lane);
}

__device__ __forceinline__ void naive_attn(const Ctx& F, int l, int c, int kvh, unsigned char* lds) {
    const int tid = F.tid;
    bf16* Ks = (bf16*)lds; bf16* Vs = Ks + 384 * 66;
    const int n = c % CPS; const long row0 = (long)c * CHUNK;
#pragma unroll 2
    for (int idx = tid; idx < 384 * 32; idx += NT) {
        const int r = idx >> 5, cp = idx & 31, pos = n * CHUNK - CHUNK + r; unsigned kv = 0u, vv = 0u;
        if (pos >= 0 && pos < SEQ) { const bf16* hr = F.H() + (size_t)(row0 - CHUNK + r) * DIN; kv = *(const unsigned*)(hr + C_K + kvh * 64 + cp * 2); vv = *(const unsigned*)(hr + C_V + kvh * 64 + cp * 2); }
        *(unsigned*)(Ks + r * 66 + cp * 2) = kv; *(unsigned*)(Vs + r * 66 + cp * 2) = vv;
    }
    __syncthreads();
    const int g = tid >> 7, ti = tid & 127, hq = kvh * 4 + g;
    const bf16* qrow = F.H() + (size_t)(row0 + ti) * DIN + C_Q + hq * 64;
    float q[64], o[64];
#pragma unroll
    for (int d = 0; d < 64; ++d) { q[d] = bf2f(qrow[d]) * 0.125f; o[d] = 0.f; }
    float m = F.P(P_SINK)[l * 8 + hq], lsum = 1.f;
    const float* bt = F.BIAS() + hq * 257;
#pragma unroll 1
    for (int j = 0; j <= 256; ++j) {
        const int k = ti + j, pos = n * CHUNK - CHUNK + k;
        if (pos < 0 || pos >= SEQ) continue;
        float s = 0.f; const unsigned* kr = (const unsigned*)(Ks + k * 66);
#pragma unroll
        for (int dp = 0; dp < 32; ++dp) { const unsigned w = kr[dp]; s += q[2 * dp] * bflo(w) + q[2 * dp + 1] * bfhi(w); }
        s += bt[j];
        if (s > m) { const float f = __expf(m - s); lsum *= f;
#pragma unroll
            for (int d = 0; d < 64; ++d) o[d] *= f;
            m = s; }
        const float p = __expf(s - m); lsum += p;
        const unsigned* vr = (const unsigned*)(Vs + k * 66);
#pragma unroll
        for (int dp = 0; dp < 32; ++dp) { const unsigned w = vr[dp]; o[2 * dp] += p * bflo(w); o[2 * dp + 1] += p * bfhi(w); }
    }
    const float inv = 1.f / lsum;
    const bf16* grow = F.H() + (size_t)(row0 + ti) * DIN + C_CG + hq * 64;
    bf16* orow = F.MIX() + (size_t)(row0 + ti) * DM + 512 + hq * 64;
#pragma unroll
    for (int d = 0; d < 64; d += 2) { const unsigned gw_ = *(const unsigned*)(grow + d);
        *(unsigned*)(orow + d) = pk2(o[d] * inv * silu_f(bflo(gw_)), o[d + 1] * inv * silu_f(bfhi(gw_))); }
    __syncthreads();
}
__device__ __forceinline__ void naive_mixA(const Ctx& F, int l, int c, unsigned char* lds) {
    float* vn = (float*)lds;
    const long row0 = (long)c * CHUNK; const int lane = F.lane;
#pragma unroll 1
    for (int tt = 0; tt < 16; ++tt) {
        const int t = F.wave * 16 + tt; const bf16* hr = F.H() + (size_t)(row0 + t) * DIN + C_AV + 4 * lane;
        float v[4]; float s = 0.f;
#pragma unroll
        for (int i = 0; i < 4; ++i) { v[i] = gelu_f(bf2f(hr[i])); s += v[i]; }
        const float mean = wave_sum(s) * (1.f / 256.f); float s2 = 0.f;
#pragma unroll
        for (int i = 0; i < 4; ++i) { v[i] -= mean; s2 += v[i] * v[i]; }
        const float rstd = 1.f / sqrtf(wave_sum(s2) * (1.f / 256.f) + LN_EPS);
#pragma unroll
        for (int i = 0; i < 4; ++i) vn[t * 256 + 4 * lane + i] = v[i] * rstd * F.P(P_GMLP_G)[l * 256 + 4 * lane + i] + F.P(P_GMLP_B)[l * 256 + 4 * lane + i];
    }
    __syncthreads();
    const int col = F.tid & 255, ih = F.tid >> 8, h = col >> 6;
    const float* W = F.P(P_WSP) + (size_t)(l * 4 + h) * 128 * 128;
#pragma unroll 1
    for (int ii = 0; ii < 64; ++ii) {
        const int i = ih * 64 + ii; const float* wr = W + i * 128; float acc = 0.f;
#pragma unroll 8
        for (int j = 0; j < 128; ++j) acc += wr[j] * vn[j * 256 + col];
        acc += F.P(P_BSP)[(l * 4 + h) * 128 + i];
        const bf16* hr = F.H() + (size_t)(row0 + i) * DIN;
        const float u = gelu_f(bf2f(hr[C_AU + col])), gt = silu_f(bf2f(hr[C_AG + col]));
        F.MIX()[(size_t)(row0 + i) * DM + col] = (bf16)f2bf(acc * u * gt);
    }
    __syncthreads();
}
__device__ __forceinline__ void naive_mixB(const Ctx& F, int l, int c, unsigned char* lds) {
    float* ys = (float*)lds;
    float* co = ys + 62 * 256;
    const int b = c / CPS, n = c % CPS, lane = F.lane;
#pragma unroll 1
    for (int sub = 0; sub < 4; ++sub) {
        const int p0 = n * CHUNK + sub * 32; const long grow0 = (long)b * SEQ + p0;
#pragma unroll 2
        for (int idx = F.tid; idx < 62 * 256; idx += NT) {
            const int r = idx >> 8, col = idx & 255, pos = p0 - 15 + r; float y = 0.f;
            if (pos >= 0 && pos < SEQ) { const bf16* hr = F.H() + (size_t)(grow0 - 15 + r) * DIN; y = bf2f(hr[C_BA + col]) * sigmoid_f(bf2f(hr[C_BB + col])); }
            ys[idx] = y;
        }
        __syncthreads();
        { const int col = F.tid & 255, th = F.tid >> 8; const float* cw = F.P(P_CONVW) + (size_t)l * 31 * 256 + col; const float cb = F.P(P_CONVB)[l * 256 + col];
#pragma unroll 1
          for (int tt = 0; tt < 16; ++tt) { const int t = th * 16 + tt; float acc = cb;
#pragma unroll 8
              for (int k = 0; k < 31; ++k) acc += cw[k * 256] * ys[(t + k) * 256 + col];
              co[t * 256 + col] = acc; } }
        __syncthreads();
#pragma unroll 1
        for (int tt = 0; tt < 4; ++tt) {
            const int t = F.wave * 4 + tt; float v[4]; float s = 0.f;
#pragma unroll
            for (int i = 0; i < 4; ++i) { v[i] = co[t * 256 + 4 * lane + i]; s += v[i]; }
            const float mean = wave_sum(s) * (1.f / 256.f); float s2 = 0.f;
#pragma unroll
            for (int i = 0; i < 4; ++i) { v[i] -= mean; s2 += v[i] * v[i]; }
            const float rstd = 1.f / sqrtf(wave_sum(s2) * (1.f / 256.f) + LN_EPS);
            const bf16* hr = F.H() + (size_t)(grow0 + t) * DIN + C_BG + 4 * lane;
            bf16* orow = F.MIX() + (size_t)(grow0 + t) * DM + 256 + 4 * lane;
#pragma unroll
            for (int i = 0; i < 4; ++i) { const float y = v[i] * rstd * F.P(P_CONVG)[l * 256 + 4 * lane + i] + F.P(P_CONVBB)[l * 256 + 4 * lane + i];
                orow[i] = (bf16)f2bf(silu_f(y) * silu_f(bf2f(hr[i]))); }
        }
        __syncthreads();
    }
}

__global__ void __launch_bounds__(NT, 2) fwd(Args args) {
    extern __shared__ __attribute__((aligned(16))) unsigned char lds[];
    cg::grid_group grid = cg::this_grid();
    Ctx F;
    F.tid = threadIdx.x; F.lane = F.tid & 63; F.wave = __builtin_amdgcn_readfirstlane(F.tid >> 6); F.G = gridDim.x; F.bid = blockIdx.x;
    F.ws = args.ws; F.out = args.out;

    prologue(F, args, lds);
    grid.sync();
#pragma unroll 1
    for (int l = 0; l < DEPTH; ++l) {
        {
            pg8::Gemm g{F.XN(), F.WIN() + (size_t)l * DIN * DM, M, DIN, DM}; pg8::StaticOrder S; S.init(M, DIN, F.G, F.bid);
            pg8::EpiBf16<0> E{F.H(), DIN, nullptr, 0, 0, 1.f};
            pg8::gemm_phase<pg8::EpiBf16<0>, pg8::StaticOrder, true, true>((PG8_LAS unsigned char*)lds, g, S, E);
        }
        grid.sync();
        {   const Ctx P = fresh(F);
            for (int c = P.bid; c < NCHUNK; c += P.G) {
                naive_attn(P, l, c, 0, lds); naive_attn(P, l, c, 1, lds);
                naive_mixA(P, l, c, lds); naive_mixB(P, l, c, lds);
            } }
        grid.sync();
        {
            pg8::Gemm g{F.MIX(), F.WOUT() + (size_t)l * DM * DM, M, DM, DM}; pg8::StaticOrder S; S.init(M, DM, F.G, F.bid);
            pg8::EpiResF32 E{F.out, F.out, DM, ALPHA};
            pg8::gemm_phase<pg8::EpiResF32, pg8::StaticOrder, true, true>((PG8_LAS unsigned char*)lds, g, S, E);
        }
        grid.sync();
        { const Ctx P = fresh(F); post_ln(P, l); }
        if (l + 1 < DEPTH) grid.sync();
    }
}

extern "C" void kernel_launch(void* const* d_in, const int* in_sizes, int n_in, void* d_out, int out_size, void* d_ws, size_t ws_size, hipStream_t stream) {
    static int grid = 0;
    if (grid == 0) {
        if (n_in != 17 || out_size != M * DM || ws_size < WS_END) { fprintf(stderr, "kernel_launch: unexpected shapes n_in %d out %d ws %zu\n", n_in, out_size, ws_size); grid = -1; return; }
        int dev = 0, cus = 0, per_cu = 0;
        (void)hipGetDevice(&dev);
        (void)hipDeviceGetAttribute(&cus, hipDeviceAttributeMultiprocessorCount, dev);
        (void)hipFuncSetAttribute((const void*)fwd, hipFuncAttributeMaxDynamicSharedMemorySize, LDS_BYTES);
        (void)hipOccupancyMaxActiveBlocksPerMultiprocessor(&per_cu, (const void*)fwd, NT, LDS_BYTES);
        if (per_cu < 1) fprintf(stderr, "kernel_launch: occupancy query reports %d blocks per CU\n", per_cu);
        grid = cus;
    }
    if (grid < 0) return;
    Args a{};
    for (int i = 0; i < 17; ++i) a.in[i] = (const float*)d_in[i];
    a.out = (float*)d_out; a.ws = (unsigned char*)d_ws;
    void* kargs[] = {&a};
    hipError_t e = hipLaunchCooperativeKernel((void*)fwd, dim3(grid), dim3(NT), kargs, LDS_BYTES, stream);
    if (e != hipSuccess) fprintf(stderr, "cooperative launch failed: %s (grid %d)\n", hipGetErrorString(e), grid);
}
```

```cpp
#include <hip/hip_runtime.h>
#include <hip/hip_cooperative_groups.h>
#include <cstdio>
#include <cstdint>
namespace cg = cooperative_groups;
namespace pg8 {
#define PG8_LAS __attribute__((address_space(3)))
typedef unsigned short bf16_t;
typedef short bf16x8 __attribute__((ext_vector_type(8)));
typedef float f32x4 __attribute__((ext_vector_type(4)));
typedef unsigned u32x4 __attribute__((ext_vector_type(4)));
constexpr int BM = 256, BK = 64, HALF = 128, HTB = HALF * BK * 2  , STAGE_BYTES = 8 * HTB, NXCD = 8, WGM = 8;

__host__ __device__ __forceinline__ int lds_byte(int r, int c) { const int st = (r >> 4) * 2 + (c >> 5), rr = r & 15, cc = c & 31, ob = rr * 64 + cc * 2; return st * 1024 + (ob ^ (((ob >> 9) & 1) << 5)); }
__host__ __device__ __forceinline__ void stage_rc(int b, int& R, int& C) { const int st = b / 1024, sb = b % 1024, swz = sb ^ (((sb >> 9) & 1) << 5); R = (st >> 1) * 16 + swz / 64; C = (st & 1) * 32 + (swz % 64) / 2; }
__host__ __device__ __forceinline__ int perm32(int rho) { const int n = rho >> 4, i = rho & 15; return 8 * (i >> 2) + 4 * n + (i & 3); }

struct Unit { int pm, pn; };
struct Gemm { const bf16_t* A; const bf16_t* Bt; int M, N, K; };

struct StaticOrder {
    int nM, nN, nwg, G, c;
    __host__ __device__ void init(int M, int N, int G_, int c_) { nM = M / BM; nN = N / BM; nwg = nM * nN; G = G_; c = c_; }
    __host__ __device__ bool next(int i, Unit& u) const {
        const long L = (long)i * G + c; if (L >= nwg) return false;
        int wgid = (int)L; { const int q = nwg / NXCD, r = nwg % NXCD, xcd = wgid % NXCD, off = wgid / NXCD; wgid = (xcd < r ? xcd * (q + 1) : r * (q + 1) + (xcd - r) * q) + off; }
        const int nig = WGM * nN, gid = wgid / nig, fm = gid * WGM, gsz = (nM - fm) < WGM ? (nM - fm) : WGM;
        u.pm = fm + ((wgid % nig) % gsz); u.pn = (wgid % nig) / gsz; return true;
    }
    __device__ __forceinline__ void a_ready(const Unit&) const {}
    __device__ __forceinline__ void done(const Unit&) const {}
};

__device__ __forceinline__ unsigned cvt_pk_bf16(float lo, float hi) { unsigned r; asm volatile("v_cvt_pk_bf16_f32 %0, %1, %2" : "=v"(r) : "v"(lo), "v"(hi)); return r; }
typedef float f32x2 __attribute__((ext_vector_type(2)));
__device__ __forceinline__ f32x2 gelu_pk(f32x2 v) {
    const f32x2 av = __builtin_elementwise_abs(v), d = av * 0.2316418882f + 1.0f;
    f32x2 t; t.x = __builtin_amdgcn_rcpf(d.x); t.y = __builtin_amdgcn_rcpf(d.y);
    f32x2 q = t * 0.5307027145f + (-0.7265760135f); q = q * t + 0.7107068705f; q = q * t + (-0.142248368f); q = q * t + 0.127414796f; q = q * t;
    const f32x2 s = (v * v) * (-0.72134752044f);
    f32x2 e; e.x = __builtin_amdgcn_exp2f(s.x); e.y = __builtin_amdgcn_exp2f(s.y);
    const f32x2 m = v * (q * e), r = v - m;
    f32x2 o; o.x = v.x < 0.f ? m.x : r.x; o.y = v.y < 0.f ? m.y : r.y; return o;
}

template <int ACT  > struct EpiBf16 {
    static constexpr bool PERM = true, AFTER_DRAIN = false; static_assert(ACT == 0 || ACT == 1, "EpiBf16: ACT is 0 (none) or 1 (gelu_pk)");
    bf16_t* O; int ldc; const float* bias; int split_cols; size_t split_stride; float scale0;
    __device__ __forceinline__ void operator()(const f32x4 (&acc)[2][2][4][2], const Unit& u, int wr, int wc, int fr, int fq) const {
        const int row0 = u.pm * BM + wr * 64 + fr; int colt = u.pn * BM; bf16_t* base = O;
        float sc = 1.f; if (split_cols) { const int t = colt / split_cols; base += (size_t)t * split_stride; colt -= t * split_cols; if (t == 0) sc = scale0; }
        const int col0 = colt + wc * 32 + 8 * fq, bcol0 = u.pn * BM + wc * 32 + 8 * fq;
        f32x4 bv[2][2];
#pragma unroll
        for (int bj = 0; bj < 2; ++bj)
#pragma unroll
            for (int n = 0; n < 2; ++n) bv[bj][n] = bias ? *(const f32x4*)(bias + bcol0 + bj * HALF + 4 * n) : (f32x4){0.f, 0.f, 0.f, 0.f};
#pragma unroll
        for (int ai = 0; ai < 2; ++ai)
#pragma unroll
            for (int m = 0; m < 4; ++m) { bf16_t* rowp = base + (size_t)(row0 + ai * HALF + m * 16) * ldc + col0;
#pragma unroll
                for (int bj = 0; bj < 2; ++bj) { f32x4 v0 = acc[ai][bj][m][0] + bv[bj][0], v1 = acc[ai][bj][m][1] + bv[bj][1];
                    if (ACT == 1) { f32x2 a = gelu_pk((f32x2){v0[0], v0[1]}), b = gelu_pk((f32x2){v0[2], v0[3]}), c = gelu_pk((f32x2){v1[0], v1[1]}), d = gelu_pk((f32x2){v1[2], v1[3]});
                        v0 = (f32x4){a.x, a.y, b.x, b.y}; v1 = (f32x4){c.x, c.y, d.x, d.y}; }
                    v0 = v0 * sc; v1 = v1 * sc; u32x4 w; w.x = cvt_pk_bf16(v0[0], v0[1]); w.y = cvt_pk_bf16(v0[2], v0[3]); w.z = cvt_pk_bf16(v1[0], v1[1]); w.w = cvt_pk_bf16(v1[2], v1[3]);
                    *(u32x4*)(rowp + bj * HALF) = w; } }
    }
};

struct PanelStats {
    unsigned* xbuf;
    unsigned* cnt;
    unsigned* tmo;
    int ntn; float eps;
    unsigned code;
    __device__ __forceinline__ bool run(const f32x4 (&v)[2][2][4][2], const Unit& u, int wr, int wc, int fr, int fq, PG8_LAS unsigned char* lds, int wid, int lane) const {
        typedef float f32x2v __attribute__((ext_vector_type(2)));
        PG8_LAS f32x2v* P = (PG8_LAS f32x2v*)lds;
        PG8_LAS f32x2v* S = (PG8_LAS f32x2v*)(lds + 8192);
        PG8_LAS unsigned* flag = (PG8_LAS unsigned*)(lds + 8192 + 2048);
#pragma unroll
        for (int ai = 0; ai < 2; ++ai)
#pragma unroll
            for (int m = 0; m < 4; ++m) {
                float s = 0.f;
#pragma unroll
                for (int bj = 0; bj < 2; ++bj)
#pragma unroll
                    for (int n = 0; n < 2; ++n) { const f32x4 x = v[ai][bj][m][n]; s += (x[0] + x[1]) + (x[2] + x[3]); }
                s += __shfl_xor(s, 16); s += __shfl_xor(s, 32);
                const float mw = s * (1.0f / 64.0f); float q = 0.f;
#pragma unroll
                for (int bj = 0; bj < 2; ++bj)
#pragma unroll
                    for (int n = 0; n < 2; ++n) { const f32x4 d = v[ai][bj][m][n] - mw; q += (d[0] * d[0] + d[1] * d[1]) + (d[2] * d[2] + d[3] * d[3]); }
                q += __shfl_xor(q, 16); q += __shfl_xor(q, 32);
                if (fq == 0) P[(ai * HALF + wr * 64 + m * 16 + fr) * 4 + wc] = (f32x2v){mw, q};
            }
        asm volatile("s_waitcnt lgkmcnt(0)" ::: "memory"); __builtin_amdgcn_s_barrier(); asm volatile("" ::: "memory");
#if defined(BROKEN_EXCHANGE_NO_WAIT)
#warning BROKEN CONTROL BUILD: the row-statistics exchange does not wait; results are wrong by design
        if (blockIdx.x >= 64) { const long long t0_ = clock64(); while (clock64() - t0_ < 60000) __builtin_amdgcn_s_sleep(8); }
#endif
        const int row = wid * 32 + (lane & 31);
        if (lane < 32) {
            const f32x2v a = P[row * 4 + 0], b = P[row * 4 + 1], c = P[row * 4 + 2], d = P[row * 4 + 3];
            const float mt = (a.x + b.x + c.x + d.x) * 0.25f;
            const float da = a.x - mt, db = b.x - mt, dc = c.x - mt, dd = d.x - mt;
            const float m2 = (a.y + b.y) + (c.y + d.y) + 64.0f * ((da * da + db * db) + (dc * dc + dd * dd));
            unsigned long long* slot = (unsigned long long*)xbuf + ((size_t)(u.pm * BM + row) * 4 + u.pn);
            __hip_atomic_store(slot, ((unsigned long long)__float_as_uint(m2) << 32) | __float_as_uint(mt), __ATOMIC_RELAXED, __HIP_MEMORY_SCOPE_AGENT);
        }
        asm volatile("s_waitcnt vmcnt(0)" ::: "memory");
        if (lane == 0) __hip_atomic_fetch_add(cnt + 64 * u.pm, 1u, __ATOMIC_RELAXED, __HIP_MEMORY_SCOPE_AGENT);
        if (wid == 0) {
            bool dead = false; const unsigned long long t0 = __builtin_amdgcn_s_memrealtime(); const unsigned want = 8u * (unsigned)ntn;
            for (;;) {
#if defined(BROKEN_EXCHANGE_NO_WAIT)
                break;
#endif
                if ((unsigned)__builtin_amdgcn_readfirstlane(__hip_atomic_load(cnt + 64 * u.pm, __ATOMIC_RELAXED, __HIP_MEMORY_SCOPE_AGENT)) >= want) break;
                if (__builtin_amdgcn_s_memrealtime() - t0 > 2000000ull) {
                    if (lane == 0) { unsigned expect = 0u; __hip_atomic_compare_exchange_strong(tmo + 1, &expect, code | (unsigned)(u.pm & 0xff), __ATOMIC_RELAXED, __ATOMIC_RELAXED, __HIP_MEMORY_SCOPE_AGENT);
                                     __hip_atomic_store(tmo, 1u, __ATOMIC_RELAXED, __HIP_MEMORY_SCOPE_AGENT); }
                    dead = true; break; }
                __builtin_amdgcn_s_sleep(2);
            }
            __builtin_amdgcn_fence(__ATOMIC_ACQUIRE, "agent");
            if (lane == 0) flag[0] = dead ? 1u : 0u;
        }
        asm volatile("s_waitcnt vmcnt(0) lgkmcnt(0)" ::: "memory"); __builtin_amdgcn_s_barrier(); asm volatile("" ::: "memory");
        const bool bad = flag[0] != 0u;
        if (lane < 32) {
            const unsigned long long* slot = (const unsigned long long*)xbuf + (size_t)(u.pm * BM + row) * 4; float mt[4], m2[4]; float ms = 0.f;
#pragma unroll
            for (int t = 0; t < 4; ++t) { if (t < ntn) { const unsigned long long w = __hip_atomic_load(slot + t, __ATOMIC_RELAXED, __HIP_MEMORY_SCOPE_AGENT); mt[t] = __uint_as_float((unsigned)w); m2[t] = __uint_as_float((unsigned)(w >> 32)); } else { mt[t] = 0.f; m2[t] = 0.f; } ms += mt[t]; }
            const float mean = ms / (float)ntn; float q = 0.f;
#pragma unroll
            for (int t = 0; t < 4; ++t) if (t < ntn) { const float dm = mt[t] - mean; q += m2[t] + 256.0f * dm * dm; }
            S[row] = (f32x2v){mean, 1.0f / sqrtf(q / (256.0f * (float)ntn) + eps)};
        }
        asm volatile("s_waitcnt lgkmcnt(0)" ::: "memory"); __builtin_amdgcn_s_barrier(); asm volatile("" ::: "memory");
        return bad;
    }
};
struct EpiLnRes {
    static constexpr bool PERM = false, AFTER_DRAIN = true;
    const float* base; float* out; int ldc; const float* bias; PanelStats st; unsigned poison;
    __device__ __forceinline__ void fused(f32x4 (&acc)[2][2][4][2], const Unit& u, int wr, int wc, int fr, int fq, PG8_LAS unsigned char* lds, int wid, int lane) const {
        typedef float f32x2v __attribute__((ext_vector_type(2)));
        const PG8_LAS f32x2v* S = (const PG8_LAS f32x2v*)(lds + 8192);
        const int col0 = u.pn * BM + wc * 32 + 4 * fq;
#pragma unroll
        for (int bj = 0; bj < 2; ++bj)
#pragma unroll
            for (int n = 0; n < 2; ++n) { const f32x4 bv = bias ? *(const f32x4*)(bias + col0 + bj * HALF + n * 16) : (f32x4){0.f, 0.f, 0.f, 0.f};
#pragma unroll
                for (int ai = 0; ai < 2; ++ai)
#pragma unroll
                    for (int m = 0; m < 4; ++m) acc[ai][bj][m][n] += bv; }
        f32x4 pre[4][2][2];
#pragma unroll
        for (int m = 0; m < 4; ++m) { const size_t off = (size_t)(u.pm * BM + wr * 64 + m * 16 + fr) * ldc + col0;
#pragma unroll
            for (int bj = 0; bj < 2; ++bj)
#pragma unroll
                for (int n = 0; n < 2; ++n) pre[m][bj][n] = *(const f32x4*)(base + off + bj * HALF + n * 16); }
        const bool bad = st.run(acc, u, wr, wc, fr, fq, lds, wid, lane) || poison != 0u;
        const float qnan = __builtin_nanf("");
#pragma unroll
        for (int ai = 0; ai < 2; ++ai)
#pragma unroll
            for (int m = 0; m < 4; ++m) { const int r = ai * HALF + wr * 64 + m * 16 + fr; const f32x2v sr = S[r]; const size_t off = (size_t)(u.pm * BM + r) * ldc + col0;
#pragma unroll
                for (int bj = 0; bj < 2; ++bj)
#pragma unroll
                    for (int n = 0; n < 2; ++n) { const f32x4 bs = ai == 0 ? pre[m][bj][n] : *(const f32x4*)(base + off + bj * HALF + n * 16); f32x4 o = bs + (acc[ai][bj][m][n] - sr.x) * sr.y;
                        if (bad) o = (f32x4){qnan, qnan, qnan, qnan}; *(f32x4*)(out + off + bj * HALF + n * 16) = o; }
                if (m & 1) asm volatile("" ::: "memory"); }
    }
};
struct EpiLnResLn {
    static constexpr bool PERM = false, AFTER_DRAIN = true;
    const float* base; float* out; bf16_t* xn; int ldc; const float* bias; PanelStats st1, st2; unsigned poison;
    __device__ __forceinline__ void fused(f32x4 (&acc)[2][2][4][2], const Unit& u, int wr, int wc, int fr, int fq, PG8_LAS unsigned char* lds, int wid, int lane) const {
        typedef float f32x2v __attribute__((ext_vector_type(2))); typedef unsigned u32x2v __attribute__((ext_vector_type(2)));
        const PG8_LAS f32x2v* S = (const PG8_LAS f32x2v*)(lds + 8192);
        const int col0 = u.pn * BM + wc * 32 + 4 * fq;
#pragma unroll
        for (int bj = 0; bj < 2; ++bj)
#pragma unroll
            for (int n = 0; n < 2; ++n) { const f32x4 bv = bias ? *(const f32x4*)(bias + col0 + bj * HALF + n * 16) : (f32x4){0.f, 0.f, 0.f, 0.f};
#pragma unroll
                for (int ai = 0; ai < 2; ++ai)
#pragma unroll
                    for (int m = 0; m < 4; ++m) acc[ai][bj][m][n] += bv; }
        bool bad = st1.run(acc, u, wr, wc, fr, fq, lds, wid, lane) || poison != 0u;
        const float qnan = __builtin_nanf("");
#pragma unroll
        for (int ai = 0; ai < 2; ++ai)
#pragma unroll
            for (int m = 0; m < 4; ++m) { const int r = ai * HALF + wr * 64 + m * 16 + fr; const f32x2v sr = S[r]; const size_t off = (size_t)(u.pm * BM + r) * ldc + col0;
#pragma unroll
                for (int bj = 0; bj < 2; ++bj)
#pragma unroll
                    for (int n = 0; n < 2; ++n) { const f32x4 bs = *(const f32x4*)(base + off + bj * HALF + n * 16); acc[ai][bj][m][n] = bs + (acc[ai][bj][m][n] - sr.x) * sr.y; }
                asm volatile("" : "+v"(acc[ai][0][m][0]), "+v"(acc[ai][0][m][1]), "+v"(acc[ai][1][m][0]), "+v"(acc[ai][1][m][1]));
                if (m & 1) asm volatile("" ::: "memory"); }
        const bool bad1 = bad;
        bad = st2.run(acc, u, wr, wc, fr, fq, lds, wid, lane) || bad;
#pragma unroll
        for (int ai = 0; ai < 2; ++ai)
#pragma unroll
            for (int m = 0; m < 4; ++m) { const int r = ai * HALF + wr * 64 + m * 16 + fr; const f32x2v sr = S[r]; const size_t off = (size_t)(u.pm * BM + r) * ldc + col0;
#pragma unroll
                for (int bj = 0; bj < 2; ++bj)
#pragma unroll
                    for (int n = 0; n < 2; ++n) { const f32x4 x1 = acc[ai][bj][m][n]; *(f32x4*)(out + off + bj * HALF + n * 16) = bad1 ? (f32x4){qnan, qnan, qnan, qnan} : x1;
                        const f32x4 o = (x1 - sr.x) * sr.y; u32x2v w; w.x = cvt_pk_bf16(o[0], o[1]); w.y = cvt_pk_bf16(o[2], o[3]);
                        if (bad) { w.x = 0x7fc07fc0u; w.y = 0x7fc07fc0u; } *(u32x2v*)(xn + off + bj * HALF + n * 16) = w; }
                asm volatile("" ::: "memory"); }
    }
};

template <class Epi, class Sched, bool ALIGN_EPI = false, bool SP2 = false>
__device__ __forceinline__ void gemm_phase(PG8_LAS unsigned char* lds, const Gemm g, const Sched& S, const Epi& E, int wave_in) {
    int lane_; asm volatile("v_mbcnt_lo_u32_b32 %0, -1, 0\n\tv_mbcnt_hi_u32_b32 %0, -1, %0" : "=v"(lane_));
    int wid_ = wave_in; asm volatile("" : "+s"(wid_));
    const int wid = wid_, lane = lane_, tid = wid * 64 + lane, wr = wid >> 2, wc = wid & 3, fr = lane & 15, fq = lane >> 4;
    const int K = g.K, nt = K / BK;
    unsigned voffA[2], voffB[2];
#pragma unroll
    for (int i = 0; i < 2; ++i) { int R, C; stage_rc(tid * 16 + i * 8192, R, C); const int Rb = Epi::PERM ? ((R & ~31) + perm32(R & 31)) : R;
        voffA[i] = (unsigned)(R * K + C) * 2u; voffB[i] = (unsigned)(Rb * K + C) * 2u; }
    const size_t kstep = (size_t)(BK * 2);
    const size_t hstep = (size_t)HALF * K * 2;
    const size_t tstep = 2 * hstep;
    const unsigned ldsw = (unsigned)wid * 1024u;
    const int aoff = lds_byte(wr * 64 + fr, fq * 8), boff = lds_byte(wc * 32 + fr, fq * 8);
#define PG8_SA(b, h) (((b) * 2 + (h)) * HTB)
#define PG8_SB(b, h) ((4 + (b) * 2 + (h)) * HTB)
#define PG8_STAGE(bufoff, gbase, voff) do { _Pragma("unroll") for (int _i = 0; _i < 2; ++_i) \
        __builtin_amdgcn_global_load_lds((const unsigned*)((const char*)(gbase) + (voff)[_i]), (PG8_LAS unsigned*)(lds + (bufoff) + ldsw + _i * 8192), 16, 0, 0); } while (0)
#define PG8_LDA(dst, b, h) do { _Pragma("unroll") for (int m = 0; m < 4; ++m) _Pragma("unroll") for (int k = 0; k < 2; ++k) dst[m][k] = *(const PG8_LAS bf16x8*)(lds + PG8_SA(b, h) + aoff + m * 2048 + k * 1024); } while (0)
#define PG8_LDB(dst, b, h) do { _Pragma("unroll") for (int n = 0; n < 2; ++n) _Pragma("unroll") for (int k = 0; k < 2; ++k) dst[n][k] = *(const PG8_LAS bf16x8*)(lds + PG8_SB(b, h) + boff + n * 2048 + k * 1024); } while (0)
#define PG8_MMA(ai, bj, At, Bt) do { __builtin_amdgcn_s_setprio(1); _Pragma("unroll") for (int m = 0; m < 4; ++m) _Pragma("unroll") for (int n = 0; n < 2; ++n) _Pragma("unroll") for (int k = 0; k < 2; ++k) \
        acc[ai][bj][m][n] = __builtin_amdgcn_mfma_f32_16x16x32_bf16(Bt[n][k], At[m][k], acc[ai][bj][m][n], 0, 0, 0); __builtin_amdgcn_s_setprio(0); } while (0)
#define PG8_WAIT_V(n) asm volatile("s_waitcnt vmcnt(" #n ")" ::: "memory")
#define PG8_WAIT_L(n) asm volatile("s_waitcnt lgkmcnt(" #n ")" ::: "memory")
#define PG8_BAR __builtin_amdgcn_s_barrier()
#define PG8_SCHED __builtin_amdgcn_sched_barrier(0)
    Unit cur, nxt; int ui = 0;
    if (!S.next(0, cur)) return;
    f32x4 acc[2][2][4][2];
#pragma unroll
    for (int a = 0; a < 2; ++a)
#pragma unroll
        for (int b = 0; b < 2; ++b)
#pragma unroll
            for (int m = 0; m < 4; ++m)
#pragma unroll
                for (int n = 0; n < 2; ++n) acc[a][b][m][n] = (f32x4){0.f, 0.f, 0.f, 0.f};
    bf16x8 At[4][2], B0[2][2], B1[2][2];
    const char* cA = (const char*)g.A + (size_t)cur.pm * tstep; const char* cB = (const char*)g.Bt + (size_t)cur.pn * tstep;
    S.a_ready(cur);
    if constexpr (SP2) {
        PG8_STAGE(PG8_SB(0, 0), cB, voffB); PG8_STAGE(PG8_SB(0, 1), cB + hstep, voffB); PG8_STAGE(PG8_SA(0, 0), cA, voffA); PG8_STAGE(PG8_SA(0, 1), cA + hstep, voffA);
        if (wr == 1) PG8_BAR;
        PG8_WAIT_V(2); PG8_BAR;
        PG8_STAGE(PG8_SB(1, 0), cB + kstep, voffB); PG8_STAGE(PG8_SA(1, 0), cA + kstep, voffA); PG8_STAGE(PG8_SB(1, 1), cB + hstep + kstep, voffB);
        PG8_WAIT_V(6); PG8_BAR;
    } else {
        PG8_STAGE(PG8_SB(0, 0), cB, voffB); PG8_STAGE(PG8_SA(0, 0), cA, voffA); PG8_STAGE(PG8_SB(0, 1), cB + hstep, voffB); PG8_STAGE(PG8_SA(0, 1), cA + hstep, voffA);
        if (wr == 1) PG8_BAR;
        PG8_WAIT_V(4); PG8_BAR;
        PG8_STAGE(PG8_SB(1, 0), cB + kstep, voffB); PG8_STAGE(PG8_SA(1, 0), cA + kstep, voffA); PG8_STAGE(PG8_SB(1, 1), cB + hstep + kstep, voffB);
        PG8_WAIT_V(6); PG8_BAR;
    }
    for (;;) {
        const bool has_next = S.next(ui + 1, nxt);
        const char* nA = has_next ? (const char*)g.A + (size_t)nxt.pm * tstep : cA; const char* nB = has_next ? (const char*)g.Bt + (size_t)nxt.pn * tstep : cB;
        for (int t = 0; t < nt; t += 2) {
            const bool last = (t == nt - 2);
            const char* a1 = cA + (size_t)(t + 1) * kstep;
            const char* a2 = last ? nA : cA + (size_t)(t + 2) * kstep; const char* b2 = last ? nB : cB + (size_t)(t + 2) * kstep;
            const char* a3 = a2 + kstep; const char* b3 = b2 + kstep;
            if (last && has_next) S.a_ready(nxt);
            if constexpr (SP2) {
            PG8_LDB(B0, 0, 0); PG8_LDB(B1, 0, 1); PG8_SCHED; PG8_LDA(At, 0, 0); PG8_STAGE(PG8_SA(1, 1), a1 + hstep, voffA);
            PG8_WAIT_V(8); PG8_WAIT_L(0); PG8_BAR; PG8_MMA(0, 0, At, B0); PG8_MMA(0, 1, At, B1); PG8_BAR; PG8_SCHED;
            PG8_LDA(At, 0, 1); PG8_STAGE(PG8_SB(0, 0), b2, voffB); PG8_STAGE(PG8_SB(0, 1), b2 + hstep, voffB); PG8_STAGE(PG8_SA(0, 0), a2, voffA);
            PG8_WAIT_V(8); PG8_WAIT_L(0); PG8_BAR; PG8_MMA(1, 0, At, B0); PG8_MMA(1, 1, At, B1); PG8_BAR; PG8_SCHED;
            PG8_LDB(B0, 1, 0); PG8_LDB(B1, 1, 1); PG8_SCHED; PG8_LDA(At, 1, 0); PG8_STAGE(PG8_SA(0, 1), a2 + hstep, voffA);
            PG8_WAIT_V(8); PG8_WAIT_L(0); PG8_BAR; PG8_MMA(0, 0, At, B0); PG8_MMA(0, 1, At, B1); PG8_BAR; PG8_SCHED;
            PG8_LDA(At, 1, 1); PG8_STAGE(PG8_SB(1, 0), b3, voffB); PG8_STAGE(PG8_SB(1, 1), b3 + hstep, voffB); PG8_STAGE(PG8_SA(1, 0), a3, voffA);
            PG8_WAIT_V(8); PG8_WAIT_L(0); PG8_BAR; PG8_MMA(1, 0, At, B0); PG8_MMA(1, 1, At, B1); PG8_BAR; PG8_SCHED;
            } else {
            PG8_LDB(B0, 0, 0); PG8_SCHED; PG8_LDA(At, 0, 0); PG8_STAGE(PG8_SA(1, 1), a1 + hstep, voffA);
            PG8_WAIT_L(8); PG8_BAR; PG8_WAIT_L(0); PG8_MMA(0, 0, At, B0); PG8_BAR; PG8_SCHED;
            PG8_LDB(B1, 0, 1); PG8_STAGE(PG8_SB(0, 0), b2, voffB);
            PG8_BAR; PG8_WAIT_L(0); PG8_MMA(0, 1, At, B1); PG8_BAR;
            PG8_LDA(At, 0, 1); PG8_STAGE(PG8_SA(0, 0), a2, voffA);
            PG8_BAR; PG8_WAIT_L(0); PG8_MMA(1, 0, At, B0); PG8_BAR; PG8_SCHED;
            PG8_STAGE(PG8_SB(0, 1), b2 + hstep, voffB);
            PG8_WAIT_V(6); PG8_BAR; PG8_MMA(1, 1, At, B1); PG8_BAR;
            PG8_LDB(B0, 1, 0); PG8_SCHED; PG8_LDA(At, 1, 0); PG8_STAGE(PG8_SA(0, 1), a2 + hstep, voffA);
            PG8_WAIT_L(8); PG8_BAR; PG8_WAIT_L(0); PG8_MMA(0, 0, At, B0); PG8_BAR; PG8_SCHED;
            PG8_LDB(B1, 1, 1); PG8_STAGE(PG8_SB(1, 0), b3, voffB);
            PG8_BAR; PG8_WAIT_L(0); PG8_MMA(0, 1, At, B1); PG8_BAR;
            PG8_LDA(At, 1, 1); PG8_STAGE(PG8_SA(1, 0), a3, voffA);
            PG8_BAR; PG8_WAIT_L(0); PG8_MMA(1, 0, At, B0); PG8_BAR; PG8_SCHED;
            PG8_STAGE(PG8_SB(1, 1), b3 + hstep, voffB);
            PG8_WAIT_V(6); PG8_BAR; PG8_MMA(1, 1, At, B1); PG8_BAR;
            }
        }
        if constexpr (ALIGN_EPI) { if (wr == 0) PG8_BAR; }
        if constexpr (!Epi::AFTER_DRAIN) { E(acc, cur, wr, wc, fr, fq); S.done(cur); }
        if (!has_next) break;
#pragma unroll
        for (int a = 0; a < 2; ++a)
#pragma unroll
            for (int b = 0; b < 2; ++b)
#pragma unroll
                for (int m = 0; m < 4; ++m)
#pragma unroll
                    for (int n = 0; n < 2; ++n) acc[a][b][m][n] = (f32x4){0.f, 0.f, 0.f, 0.f};
        cur = nxt; cA = nA; cB = nB; ++ui;
        if constexpr (ALIGN_EPI) { if (wr == 1) PG8_BAR; }
    }
    PG8_WAIT_V(0);
    if constexpr (!ALIGN_EPI) { if (wr == 0) PG8_BAR; }
    PG8_BAR;
    if constexpr (Epi::AFTER_DRAIN) { E.fused(acc, cur, wr, wc, fr, fq, lds, wid, lane); S.done(cur); }
#undef PG8_SA
#undef PG8_SB
#undef PG8_STAGE
#undef PG8_LDA
#undef PG8_LDB
#undef PG8_MMA
#undef PG8_WAIT_V
#undef PG8_WAIT_L
#undef PG8_BAR
#undef PG8_SCHED
}
}

namespace pg8 {
struct EpiResF32 {
    static constexpr bool PERM = false, AFTER_DRAIN = false;
    const float* base; float* out; int ldc; float alpha;
    __device__ __forceinline__ void operator()(const f32x4 (&acc)[2][2][4][2], const Unit& u, int wr, int wc, int fr, int fq) const {
        const int row0 = u.pm * BM + wr * 64 + fr, col0 = u.pn * BM + wc * 32 + 4 * fq;
#pragma unroll
        for (int ai = 0; ai < 2; ++ai)
#pragma unroll
            for (int m = 0; m < 4; ++m) { const size_t off = (size_t)(row0 + ai * HALF + m * 16) * ldc + col0;
#pragma unroll
                for (int bj = 0; bj < 2; ++bj)
#pragma unroll
                    for (int n = 0; n < 2; ++n) { const f32x4 bs = *(const f32x4*)(base + off + bj * HALF + n * 16);
                        *(f32x4*)(out + off + bj * HALF + n * 16) = bs * alpha + acc[ai][bj][m][n]; } }
    }
};
}

constexpr int BATCH = 2, SEQ = 16384, DM = 1024, M = BATCH * SEQ, DIN = 2816, DEPTH = 2;
constexpr int CHUNK = 128, NCHUNK = M / CHUNK, CPS = SEQ / CHUNK;
constexpr int C_AU = 0, C_AV = 256, C_AG = 512, C_BA = 768, C_BB = 1024, C_BG = 1280, C_Q = 1536, C_K = 2048, C_V = 2176, C_CG = 2304;
constexpr float LN_EPS = 1e-5f;
constexpr float ALPHA = 1.4142135623730951f;
constexpr int NWAVES = 8, NT = 512;
constexpr int LDS_BYTES = 147456;
constexpr size_t MiB = 1u << 20;
constexpr size_t WS_WIN = 0;
constexpr size_t WS_WOUT = 12 * MiB;
constexpr size_t WS_BIAS = 17 * MiB;
constexpr size_t WS_XN = 32 * MiB;
constexpr size_t WS_H = 96 * MiB;
constexpr size_t WS_MIX = 272 * MiB;
constexpr size_t WS_END = 336 * MiB;
constexpr size_t WS_WSPB = 17 * MiB + 65536;
constexpr size_t WS_PAR = 18 * MiB;
constexpr int P_GMLP_G = 0, P_GMLP_B = 512, P_BSP = 1024, P_CONVB = 2048, P_CONVG = 2560, P_CONVBB = 3072, P_SINK = 3584, P_POSTG = 4096, P_POSTB = 6144, P_CONVW = 8192, P_WSP = 24576, P_END = 24576 + 131072;

typedef unsigned short bf16;
typedef float f32x4 __attribute__((ext_vector_type(4)));
typedef unsigned v4u __attribute__((ext_vector_type(4)));
#define LAS __attribute__((address_space(3)))

__device__ __forceinline__ float bf2f(unsigned short b) { return __uint_as_float((unsigned)b << 16); }
__device__ __forceinline__ float bflo(unsigned w) { return __uint_as_float(w << 16); }
__device__ __forceinline__ float bfhi(unsigned w) { return __uint_as_float(w & 0xffff0000u); }
__device__ __forceinline__ unsigned f2bf(float f) { unsigned u = __float_as_uint(f); return (u + 0x7fffu + ((u >> 16) & 1u)) >> 16; }
__device__ __forceinline__ unsigned pk2(float lo, float hi) { return f2bf(lo) | (f2bf(hi) << 16); }
__device__ __forceinline__ float sigmoid_f(float x) { return 1.f / (1.f + __expf(-x)); }
__device__ __forceinline__ float silu_f(float x) { return x / (1.f + __expf(-x)); }
__device__ __forceinline__ float gelu_f(float x) { const float u = 0.7978845608028654f * (x + 0.044715f * x * x * x); return x / (1.f + __expf(-2.f * u)); }
#define DPP_XADD(v, ctrl) ((v) + __builtin_bit_cast(float, __builtin_amdgcn_update_dpp(0, __builtin_bit_cast(int, (v)), (ctrl), 0xf, 0xf, true)))
__device__ __forceinline__ float wave_sum(float v) {
    v = DPP_XADD(v, 0xB1);
    v = DPP_XADD(v, 0x4E);
    v = DPP_XADD(v, 0x141);
    v = DPP_XADD(v, 0x140);
    v += __builtin_bit_cast(float, __builtin_amdgcn_ds_swizzle(__builtin_bit_cast(int, v), (16 << 10) | 0x1f));
    auto rr = __builtin_amdgcn_permlane32_swap(__float_as_uint(v), __float_as_uint(v), false, false);
    return __uint_as_float(rr[0]) + __uint_as_float(rr[1]);
}
__device__ __forceinline__ int t5_bucket(int rel) {
    const int n = rel < 0 ? -rel : rel;
    const int b = n < 8 ? n : n < 12 ? 8 : n < 16 ? 9 : n < 23 ? 10 : n < 32 ? 11 : n < 46 ? 12 : n < 64 ? 13 : n < 91 ? 14 : 15;
    return b + (rel > 0 ? 16 : 0);
}

struct Args { const float* in[17]; float* out; unsigned char* ws; };

struct Ctx {
    int tid, lane, wave, G, bid;
    unsigned char* ws; float* out;
    __device__ __forceinline__ bf16* WIN() const { return (bf16*)(ws + WS_WIN); }
    __device__ __forceinline__ bf16* WOUT() const { return (bf16*)(ws + WS_WOUT); }
    __device__ __forceinline__ bf16* XN() const { return (bf16*)(ws + WS_XN); }
    __device__ __forceinline__ bf16* H() const { return (bf16*)(ws + WS_H); }
    __device__ __forceinline__ bf16* MIX() const { return (bf16*)(ws + WS_MIX); }
    __device__ __forceinline__ float* BIAS() const { return (float*)(ws + WS_BIAS); }
    __device__ __forceinline__ const float* P(int off) const { return (const float*)(ws + WS_PAR) + off; }
};

__device__ __forceinline__ int lane_id_now() { int l; asm volatile("v_mbcnt_lo_u32_b32 %0, -1, 0\n\tv_mbcnt_hi_u32_b32 %0, -1, %0" : "=v"(l)); return l; }
__device__ __forceinline__ Ctx fresh(const Ctx& F) {
    Ctx C = F; asm volatile("" : "+s"(C.wave), "+s"(C.ws), "+s"(C.out), "+s"(C.bid), "+s"(C.G));
    C.lane = lane_id_now(); C.tid = C.wave * 64 + C.lane; return C;
}
__device__ __forceinline__ void p0_transpose_item(const float* W, int K, int N, bf16* WT, LAS float* scr, int item, int lane) {
    const int nblk = N / 32, kb = item / nblk, nb = item % nblk, k0 = 64 * kb, n0 = 32 * nb;
#pragma unroll 8
    for (int i = 0; i < 32; ++i) { const int kk = 2 * i + (lane >> 5); scr[kk * 33 + (lane & 31)] = W[(size_t)(k0 + kk) * N + n0 + (lane & 31)]; }
    asm volatile("s_waitcnt lgkmcnt(0)" ::: "memory");
    const int c = lane & 7;
#pragma unroll
    for (int j = 0; j < 4; ++j) { const int n = (lane >> 3) + 8 * j; const LAS float* s = scr + (8 * c) * 33 + n;
        v4u o; o.x = pk2(s[0 * 33], s[1 * 33]); o.y = pk2(s[2 * 33], s[3 * 33]); o.z = pk2(s[4 * 33], s[5 * 33]); o.w = pk2(s[6 * 33], s[7 * 33]);
        *(v4u*)(WT + (size_t)(n0 + n) * K + k0 + 8 * c) = o; }
    asm volatile("s_waitcnt lgkmcnt(0)" ::: "memory");
}
__device__ __forceinline__ void ln_row(const float* xrow, const float* g, const float* b, float* orow, bf16* brow, int lane) {
    const f32x4* xr = (const f32x4*)xrow + lane;
    f32x4 v[4]; float s = 0.f;
#pragma unroll
    for (int j = 0; j < 4; ++j) { v[j] = xr[64 * j]; s += (v[j].x + v[j].y) + (v[j].z + v[j].w); }
    const float mean = wave_sum(s) * (1.f / DM); float s2 = 0.f;
#pragma unroll
    for (int j = 0; j < 4; ++j) { v[j] = v[j] - mean; s2 += (v[j].x * v[j].x + v[j].y * v[j].y) + (v[j].z * v[j].z + v[j].w * v[j].w); }
    const float rstd = 1.f / sqrtf(wave_sum(s2) * (1.f / DM) + LN_EPS);
    f32x4* o4 = (f32x4*)orow + lane; unsigned long long* o8 = (unsigned long long*)brow + lane;
#pragma unroll
    for (int j = 0; j < 4; ++j) { const f32x4 gg = ((const f32x4*)g)[lane + 64 * j], bb = ((const f32x4*)b)[lane + 64 * j];
        const f32x4 y = v[j] * rstd * gg + bb; o4[64 * j] = y;
        o8[64 * j] = (unsigned long long)pk2(y.x, y.y) | ((unsigned long long)pk2(y.z, y.w) << 32); }
}
__device__ __forceinline__ void prologue(const Ctx& F, const Args& A, unsigned char* lds) {
    LAS float* scr = (LAS float*)((LAS unsigned char*)lds + F.wave * 16384);
    const int gw = F.bid * NWAVES + F.wave, NGW = F.G * NWAVES;
    constexpr int I_IN = (DM / 64) * (DIN / 32), I_OUT = (DM / 64) * (DM / 32);
    constexpr int NITEMS = DEPTH * (I_IN + I_OUT);
    for (int it = gw; it < NITEMS; it += NGW) {
        int r = it; const int l = r / (I_IN + I_OUT); r -= l * (I_IN + I_OUT);
        if (r < I_IN) p0_transpose_item(A.in[3] + (size_t)l * DM * DIN, DM, DIN, F.WIN() + (size_t)l * DIN * DM, scr, r, F.lane);
        else p0_transpose_item(A.in[14] + (size_t)l * DM * DM, DM, DM, F.WOUT() + (size_t)l * DM * DM, scr, r - I_IN, F.lane);
    }
    for (int m = gw; m < M; m += NGW) ln_row(A.in[0] + (size_t)m * DM, A.in[1], A.in[2], F.out + (size_t)m * DM, F.XN() + (size_t)m * DM, F.lane);
    if (F.bid == 0) for (int i = F.tid; i < 8 * 257; i += NT) { const int h = i / 257, rel = i % 257 - 128; F.BIAS()[i] = A.in[13][t5_bucket(rel) * 8 + h]; }
    {
        float* P = (float*)(F.ws + WS_PAR); const int gt = F.bid * NT + F.tid, GT = F.G * NT;
        for (int i = gt; i < 512; i += GT) { P[P_GMLP_G + i] = A.in[4][i]; P[P_GMLP_B + i] = A.in[5][i]; P[P_CONVB + i] = A.in[9][i]; P[P_CONVG + i] = A.in[10][i]; P[P_CONVBB + i] = A.in[11][i]; }
        for (int i = gt; i < 1024; i += GT) P[P_BSP + i] = A.in[7][i];
        for (int i = gt; i < 16; i += GT) P[P_SINK + i] = A.in[12][i];
        for (int i = gt; i < 2048; i += GT) { P[P_POSTG + i] = A.in[15][i]; P[P_POSTB + i] = A.in[16][i]; }
        for (int i = gt; i < 2 * 31 * 256; i += GT) P[P_CONVW + i] = A.in[8][i];
        for (int i = gt; i < 2 * 4 * 128 * 128; i += GT) { const float wv = A.in[6][i]; P[P_WSP + i] = wv; ((bf16*)(F.ws + WS_WSPB))[i] = (bf16)f2bf(wv); }
    }
}
__device__ __forceinline__ void post_ln(const Ctx& F, int l) {
    const int gw = F.bid * NWAVES + F.wave, NGW = F.G * NWAVES;
    for (int m = gw; m < M; m += NGW) ln_row(F.out + (size_t)m * DM, F.P(P_POSTG) + l * DM, F.P(P_POSTB) + l * DM, F.out + (size_t)m * DM, F.XN() + (size_t)m * DM, F.lane);
}

__device__ __forceinline__ void naive_attn(const Ctx& F, int l, int c, int kvh, unsigned char* lds) {
    const int tid = F.tid;
    bf16* Ks = (bf16*)lds; bf16* Vs = Ks + 384 * 66;
    const int n = c % CPS; const long row0 = (long)c * CHUNK;
#pragma unroll 2
    for (int idx = tid; idx < 384 * 32; idx += NT) {
        const int r = idx >> 5, cp = idx & 31, pos = n * CHUNK - CHUNK + r; unsigned kv = 0u, vv = 0u;
        if (pos >= 0 && pos < SEQ) { const bf16* hr = F.H() + (size_t)(row0 - CHUNK + r) * DIN; kv = *(const unsigned*)(hr + C_K + kvh * 64 + cp * 2); vv = *(const unsigned*)(hr + C_V + kvh * 64 + cp * 2); }
        *(unsigned*)(Ks + r * 66 + cp * 2) = kv; *(unsigned*)(Vs + r * 66 + cp * 2) = vv;
    }
    __syncthreads();
    const int g = tid >> 7, ti = tid & 127, hq = kvh * 4 + g;
    const bf16* qrow = F.H() + (size_t)(row0 + ti) * DIN + C_Q + hq * 64;
    float q[64], o[64];
#pragma unroll
    for (int d = 0; d < 64; ++d) { q[d] = bf2f(qrow[d]) * 0.125f; o[d] = 0.f; }
    float m = F.P(P_SINK)[l * 8 + hq], lsum = 1.f;
    const float* bt = F.BIAS() + hq * 257;
#pragma unroll 1
    for (int j = 0; j <= 256; ++j) {
        const int k = ti + j, pos = n * CHUNK - CHUNK + k;
        if (pos < 0 || pos >= SEQ) continue;
        float s = 0.f; const unsigned* kr = (const unsigned*)(Ks + k * 66);
#pragma unroll
        for (int dp = 0; dp < 32; ++dp) { const unsigned w = kr[dp]; s += q[2 * dp] * bflo(w) + q[2 * dp + 1] * bfhi(w); }
        s += bt[j];
        if (s > m) { const float f = __expf(m - s); lsum *= f;
#pragma unroll
            for (int d = 0; d < 64; ++d) o[d] *= f;
            m = s; }
        const float p = __expf(s - m); lsum += p;
        const unsigned* vr = (const unsigned*)(Vs + k * 66);
#pragma unroll
        for (int dp = 0; dp < 32; ++dp) { const unsigned w = vr[dp]; o[2 * dp] += p * bflo(w); o[2 * dp + 1] += p * bfhi(w); }
    }
    const float inv = 1.f / lsum;
    const bf16* grow = F.H() + (size_t)(row0 + ti) * DIN + C_CG + hq * 64;
    bf16* orow = F.MIX() + (size_t)(row0 + ti) * DM + 512 + hq * 64;
#pragma unroll
    for (int d = 0; d < 64; d += 2) { const unsigned gw_ = *(const unsigned*)(grow + d);
        *(unsigned*)(orow + d) = pk2(o[d] * inv * silu_f(bflo(gw_)), o[d + 1] * inv * silu_f(bfhi(gw_))); }
    __syncthreads();
}
__device__ __forceinline__ void naive_mixA(const Ctx& F, int l, int c, unsigned char* lds) {
    float* vn = (float*)lds;
    const long row0 = (long)c * CHUNK; const int lane = F.lane;
#pragma unroll 1
    for (int tt = 0; tt < 16; ++tt) {
        const int t = F.wave * 16 + tt; const bf16* hr = F.H() + (size_t)(row0 + t) * DIN + C_AV + 4 * lane;
        float v[4]; float s = 0.f;
#pragma unroll
        for (int i = 0; i < 4; ++i) { v[i] = gelu_f(bf2f(hr[i])); s += v[i]; }
        const float mean = wave_sum(s) * (1.f / 256.f); float s2 = 0.f;
#pragma unroll
        for (int i = 0; i < 4; ++i) { v[i] -= mean; s2 += v[i] * v[i]; }
        const float rstd = 1.f / sqrtf(wave_sum(s2) * (1.f / 256.f) + LN_EPS);
#pragma unroll
        for (int i = 0; i < 4; ++i) vn[t * 256 + 4 * lane + i] = v[i] * rstd * F.P(P_GMLP_G)[l * 256 + 4 * lane + i] + F.P(P_GMLP_B)[l * 256 + 4 * lane + i];
    }
    __syncthreads();
    const int col = F.tid & 255, ih = F.tid >> 8, h = col >> 6;
    const float* W = F.P(P_WSP) + (size_t)(l * 4 + h) * 128 * 128;
#pragma unroll 1
    for (int ii = 0; ii < 64; ++ii) {
        const int i = ih * 64 + ii; const float* wr = W + i * 128; float acc = 0.f;
#pragma unroll 8
        for (int j = 0; j < 128; ++j) acc += wr[j] * vn[j * 256 + col];
        acc += F.P(P_BSP)[(l * 4 + h) * 128 + i];
        const bf16* hr = F.H() + (size_t)(row0 + i) * DIN;
        const float u = gelu_f(bf2f(hr[C_AU + col])), gt = silu_f(bf2f(hr[C_AG + col]));
        F.MIX()[(size_t)(row0 + i) * DM + col] = (bf16)f2bf(acc * u * gt);
    }
    __syncthreads();
}
__device__ __forceinline__ void naive_mixB(const Ctx& F, int l, int c, unsigned char* lds) {
    float* ys = (float*)lds;
    float* co = ys + 62 * 256;
    const int b = c / CPS, n = c % CPS, lane = F.lane;
#pragma unroll 1
    for (int sub = 0; sub < 4; ++sub) {
        const int p0 = n * CHUNK + sub * 32; const long grow0 = (long)b * SEQ + p0;
#pragma unroll 2
        for (int idx = F.tid; idx < 62 * 256; idx += NT) {
            const int r = idx >> 8, col = idx & 255, pos = p0 - 15 + r; float y = 0.f;
            if (pos >= 0 && pos < SEQ) { const bf16* hr = F.H() + (size_t)(grow0 - 15 + r) * DIN; y = bf2f(hr[C_BA + col]) * sigmoid_f(bf2f(hr[C_BB + col])); }
            ys[idx] = y;
        }
        __syncthreads();
        { const int col = F.tid & 255, th = F.tid >> 8; const float* cw = F.P(P_CONVW) + (size_t)l * 31 * 256 + col; const float cb = F.P(P_CONVB)[l * 256 + col];
#pragma unroll 1
          for (int tt = 0; tt < 16; ++tt) { const int t = th * 16 + tt; float acc = cb;
#pragma unroll 8
              for (int k = 0; k < 31; ++k) acc += cw[k * 256] * ys[(t + k) * 256 + col];
              co[t * 256 + col] = acc; } }
        __syncthreads();
#pragma unroll 1
        for (int tt = 0; tt < 4; ++tt) {
            const int t = F.wave * 4 + tt; float v[4]; float s = 0.f;
#pragma unroll
            for (int i = 0; i < 4; ++i) { v[i] = co[t * 256 + 4 * lane + i]; s += v[i]; }
            const float mean = wave_sum(s) * (1.f / 256.f); float s2 = 0.f;
#pragma unroll
            for (int i = 0; i < 4; ++i) { v[i] -= mean; s2 += v[i] * v[i]; }
            const float rstd = 1.f / sqrtf(wave_sum(s2) * (1.f / 256.f) + LN_EPS);
            const bf16* hr = F.H() + (size_t)(grow0 + t) * DIN + C_BG + 4 * lane;
            bf16* orow = F.MIX() + (size_t)(grow0 + t) * DM + 256 + 4 * lane;
#pragma unroll
            for (int i = 0; i < 4; ++i) { const float y = v[i] * rstd * F.P(P_CONVG)[l * 256 + 4 * lane + i] + F.P(P_CONVBB)[l * 256 + 4 * lane + i];
                orow[i] = (bf16)f2bf(silu_f(y) * silu_f(bf2f(hr[i]))); }
        }
        __syncthreads();
    }
}


typedef short bf16x8 __attribute__((ext_vector_type(8)));
typedef float f32x16 __attribute__((ext_vector_type(16)));
typedef short v4i16_t __attribute__((ext_vector_type(4)));
typedef unsigned u32x2 __attribute__((ext_vector_type(2)));
typedef float f32x2_t __attribute__((ext_vector_type(2)));
typedef __bf16 bf16x2_t __attribute__((ext_vector_type(2)));
constexpr float LOG2E = 1.4426950408889634f;
constexpr float C2 = 0.125f * LOG2E;
__device__ __forceinline__ unsigned cvtpk(float lo, float hi) { f32x2_t v = {lo, hi}; bf16x2_t b = __builtin_convertvector(v, bf16x2_t); return __builtin_bit_cast(unsigned, b); }
__device__ __forceinline__ v4i16_t trread(const LAS unsigned char* p) { return __builtin_amdgcn_ds_read_tr16_b64_v4i16((LAS v4i16_t*)p); }
__device__ __forceinline__ bf16x8 mk8(v4i16_t lo, v4i16_t hi) { return (bf16x8){lo[0], lo[1], lo[2], lo[3], hi[0], hi[1], hi[2], hi[3]}; }
__device__ __forceinline__ float swapmax(float v) { auto rr = __builtin_amdgcn_permlane32_swap(__float_as_uint(v), __float_as_uint(v), false, false); return fmaxf(__uint_as_float(rr[0]), __uint_as_float(rr[1])); }
__device__ __forceinline__ float swapsum(float v) { auto rr = __builtin_amdgcn_permlane32_swap(__float_as_uint(v), __float_as_uint(v), false, false); return __uint_as_float(rr[0]) + __uint_as_float(rr[1]); }
#define MFMA32(a, b, c) __builtin_amdgcn_mfma_f32_32x32x16_bf16((a), (b), (c), 0, 0, 0)
#define F16Z (f32x16){0.f,0.f,0.f,0.f,0.f,0.f,0.f,0.f,0.f,0.f,0.f,0.f,0.f,0.f,0.f,0.f}

constexpr int A_K = 0, A_V = 49152, A_T = 98304, A_S = 106496, A_SP = 4608;
__device__ __forceinline__ void attn_unit(const Ctx& Fin, int l, int c, int kvh, LAS unsigned char* L) {
    const Ctx F = fresh(Fin);
    const int tid = F.tid, lane = F.lane, wave = F.wave, r32 = lane & 31, hi = lane >> 5;
    const int n = c % CPS; const long row0 = (long)c * CHUNK;
    const bf16* H = F.H();
#pragma unroll 2
    for (int idx = tid; idx < 3072; idx += NT) {
        const int r = idx >> 3, ch = idx & 7, pos = n * CHUNK - CHUNK + r; v4u kk = {0u, 0u, 0u, 0u}, vv = {0u, 0u, 0u, 0u};
        if (pos >= 0 && pos < SEQ) { const bf16* hr = H + (size_t)(row0 - CHUNK + r) * DIN + kvh * 64 + ch * 8; kk = *(const v4u*)(hr + C_K); vv = *(const v4u*)(hr + C_V); }
        *(LAS v4u*)(L + A_K + r * 128 + ((ch ^ ((r >> 1) & 7)) << 4)) = kk;
        *(LAS v4u*)(L + A_V + ((r >> 3) * 2 + (ch >> 2)) * 512 + (r & 7) * 64 + (ch & 3) * 16) = vv;
    }
    LAS float* tab = (LAS float*)(L + A_T);
    for (int idx = tid; idx < 2048; idx += NT) { const int g = idx >> 9, rel = (idx & 511) - 255;
        tab[idx] = (rel >= -128 && rel <= 128) ? F.BIAS()[(kvh * 4 + g) * 257 + rel + 128] * LOG2E : -INFINITY; }
    __syncthreads();
    const int g = wave >> 1, hq = kvh * 4 + g;
    const float sink2 = F.P(P_SINK)[l * 8 + hq] * LOG2E;
    LAS unsigned char* stg = L + A_S + wave * A_SP;
    int koff[4];
#pragma unroll
    for (int d0 = 0; d0 < 4; ++d0) koff[d0] = r32 * 128 + (((2 * d0 + hi) ^ ((r32 >> 1) & 7)) << 4);
    const int i16 = lane & 15, g16 = lane >> 4;
    const int vbase = (4 * hi + (i16 >> 2)) * 64 + 32 * (g16 & 1) + 8 * (i16 & 3);
    const LAS float* tg = tab + g * 512 + 127 - r32 + 4 * hi;
#pragma unroll 1
    for (int sb = 0; sb < 2; ++sb) {
        const int j = 2 * (wave & 1) + sb, q0 = 32 * j;
        int tlo = j < 2 ? 0 : 1, thi = j < 2 ? 5 : 6; if (n == 0) tlo = 2; if (n == CPS - 1) thi = 4;
        bf16x8 qf[4]; const bf16* qp = H + (size_t)(row0 + q0 + r32) * DIN + C_Q + hq * 64 + 8 * hi;
#pragma unroll
        for (int d0 = 0; d0 < 4; ++d0) qf[d0] = *(const bf16x8*)(qp + 16 * d0);
        f32x16 o0 = F16Z, o1 = F16Z; float m = sink2, lsum = hi ? 0.f : 1.f;
#pragma unroll 1
        for (int t = tlo; t < thi; ++t) {
            const LAS unsigned char* kp = L + A_K + t * (64 * 128);
            f32x16 p0 = F16Z, p1 = F16Z;
#pragma unroll
            for (int d0 = 0; d0 < 4; ++d0) { const bf16x8 k0 = *(const LAS bf16x8*)(kp + koff[d0]), k1 = *(const LAS bf16x8*)(kp + 32 * 128 + koff[d0]);
                p0 = MFMA32(k0, qf[d0], p0); p1 = MFMA32(k1, qf[d0], p1); }
            const LAS float* tb = tg + t * 64 - q0;
            float mx = -INFINITY;
#pragma unroll
            for (int r = 0; r < 16; ++r) { const int cr = (r & 3) + 8 * (r >> 2); p0[r] = fmaf(p0[r], C2, tb[cr]); p1[r] = fmaf(p1[r], C2, tb[cr + 32]); mx = fmaxf(mx, fmaxf(p0[r], p1[r])); }
            mx = swapmax(mx);
            const float mn = fmaxf(m, mx), alpha = __builtin_amdgcn_exp2f(m - mn); m = mn;
            float rs = 0.f;
#pragma unroll
            for (int r = 0; r < 16; ++r) { p0[r] = __builtin_amdgcn_exp2f(p0[r] - mn); p1[r] = __builtin_amdgcn_exp2f(p1[r] - mn); rs += p0[r] + p1[r]; }
            lsum = lsum * alpha + rs;
#pragma unroll
            for (int r = 0; r < 16; ++r) { o0[r] *= alpha; o1[r] *= alpha; }
            const LAS unsigned char* vp = L + A_V + vbase + t * (16 * 512);
#pragma unroll
            for (int s = 0; s < 2; ++s) {
                v4u w; w.x = cvtpk(p0[8 * s + 0], p0[8 * s + 1]); w.y = cvtpk(p0[8 * s + 2], p0[8 * s + 3]); w.z = cvtpk(p0[8 * s + 4], p0[8 * s + 5]); w.w = cvtpk(p0[8 * s + 6], p0[8 * s + 7]);
                const bf16x8 pf = __builtin_bit_cast(bf16x8, w); const int sub = 2 * s;
                o0 = MFMA32(mk8(trread(vp + ((sub + 0) * 2 + 0) * 512), trread(vp + ((sub + 1) * 2 + 0) * 512)), pf, o0);
                o1 = MFMA32(mk8(trread(vp + ((sub + 0) * 2 + 1) * 512), trread(vp + ((sub + 1) * 2 + 1) * 512)), pf, o1);
            }
#pragma unroll
            for (int s = 0; s < 2; ++s) {
                v4u w; w.x = cvtpk(p1[8 * s + 0], p1[8 * s + 1]); w.y = cvtpk(p1[8 * s + 2], p1[8 * s + 3]); w.z = cvtpk(p1[8 * s + 4], p1[8 * s + 5]); w.w = cvtpk(p1[8 * s + 6], p1[8 * s + 7]);
                const bf16x8 pf = __builtin_bit_cast(bf16x8, w); const int sub = 4 + 2 * s;
                o0 = MFMA32(mk8(trread(vp + ((sub + 0) * 2 + 0) * 512), trread(vp + ((sub + 1) * 2 + 0) * 512)), pf, o0);
                o1 = MFMA32(mk8(trread(vp + ((sub + 0) * 2 + 1) * 512), trread(vp + ((sub + 1) * 2 + 1) * 512)), pf, o1);
            }
        }
        lsum = swapsum(lsum); const float inv = 1.f / lsum;
#pragma unroll
        for (int i = 0; i < 4; ++i) { const int id = lane + 64 * i, row = id >> 3, ch = id & 7;
            *(LAS v4u*)(stg + row * 144 + ch * 16) = *(const v4u*)(H + (size_t)(row0 + q0 + row) * DIN + C_CG + hq * 64 + ch * 8); }
#pragma unroll
        for (int a = 0; a < 4; ++a) {
            { LAS u32x2* sp = (LAS u32x2*)(stg + r32 * 144 + (8 * a + 4 * hi) * 2); const u32x2 gw = *sp; u32x2 ow;
              ow.x = cvtpk(o0[4 * a + 0] * inv * silu_f(bflo(gw.x)), o0[4 * a + 1] * inv * silu_f(bfhi(gw.x))); ow.y = cvtpk(o0[4 * a + 2] * inv * silu_f(bflo(gw.y)), o0[4 * a + 3] * inv * silu_f(bfhi(gw.y))); *sp = ow; }
            { LAS u32x2* sp = (LAS u32x2*)(stg + r32 * 144 + (32 + 8 * a + 4 * hi) * 2); const u32x2 gw = *sp; u32x2 ow;
              ow.x = cvtpk(o1[4 * a + 0] * inv * silu_f(bflo(gw.x)), o1[4 * a + 1] * inv * silu_f(bfhi(gw.x))); ow.y = cvtpk(o1[4 * a + 2] * inv * silu_f(bflo(gw.y)), o1[4 * a + 3] * inv * silu_f(bfhi(gw.y))); *sp = ow; }
        }
#pragma unroll
        for (int i = 0; i < 4; ++i) { const int id = lane + 64 * i, row = id >> 3, ch = id & 7;
            *(v4u*)(F.MIX() + (size_t)(row0 + q0 + row) * DM + 512 + hq * 64 + ch * 8) = *(const LAS v4u*)(stg + row * 144 + ch * 16); }
    }
    __syncthreads();
}

constexpr int MA_VN = 0, MA_S = 65536, MA_SP = 9216;
__device__ __forceinline__ void mixA_unit(const Ctx& Fin, int l, int c, LAS unsigned char* L) {
    const Ctx F = fresh(Fin);
    const int lane = F.lane, wave = F.wave, r32 = lane & 31, hi = lane >> 5;
    const long row0 = (long)c * CHUNK; const bf16* H = F.H();
    {   const f32x4 gg = *(const f32x4*)(F.P(P_GMLP_G) + l * 256 + 4 * lane), bb = *(const f32x4*)(F.P(P_GMLP_B) + l * 256 + 4 * lane);
#pragma unroll 4
        for (int tt = 0; tt < 16; ++tt) { const int j = wave * 16 + tt;
            const u32x2 w = *(const u32x2*)(H + (size_t)(row0 + j) * DIN + C_AV + 4 * lane);
            float v0 = gelu_f(bflo(w.x)), v1 = gelu_f(bfhi(w.x)), v2 = gelu_f(bflo(w.y)), v3 = gelu_f(bfhi(w.y));
            const float mean = wave_sum((v0 + v1) + (v2 + v3)) * (1.f / 256.f); v0 -= mean; v1 -= mean; v2 -= mean; v3 -= mean;
            const float rstd = 1.f / sqrtf(wave_sum((v0 * v0 + v1 * v1) + (v2 * v2 + v3 * v3)) * (1.f / 256.f) + LN_EPS);
            u32x2 o; o.x = cvtpk(v0 * rstd * gg.x + bb.x, v1 * rstd * gg.y + bb.y); o.y = cvtpk(v2 * rstd * gg.z + bb.z, v3 * rstd * gg.w + bb.w);
            const int col = 4 * lane;
            *(LAS u32x2*)(L + MA_VN + ((j >> 3) * 8 + (col >> 5)) * 512 + (j & 7) * 64 + (col & 31) * 2) = o; } }
    __syncthreads();
    const int i16 = lane & 15, g16 = lane >> 4;
    const int abase = hi * (8 * 512) + (i16 >> 2) * 64 + 32 * (g16 & 1) + 8 * (i16 & 3);
    LAS unsigned char* stg = L + MA_S + wave * MA_SP;
    const bf16* WS = (const bf16*)(F.ws + WS_WSPB);
#pragma unroll 1
    for (int uu = 0; uu < 2; ++uu) {
        const int combo = wave * 2 + uu, h = combo >> 2, ib = combo & 3;
        bf16x8 wf[8]; const bf16* wp = WS + ((size_t)(l * 4 + h) * 128 + 32 * ib + r32) * 128 + 8 * hi;
#pragma unroll
        for (int s = 0; s < 8; ++s) wf[s] = *(const bf16x8*)(wp + 16 * s);
        f32x16 d0 = F16Z, d1 = F16Z;
        const LAS unsigned char* ap = L + MA_VN + abase + (2 * h) * 512;
#pragma unroll
        for (int s = 0; s < 8; ++s) {
            d0 = MFMA32(mk8(trread(ap + (16 * s + 0) * 512), trread(ap + (16 * s + 0) * 512 + 256)), wf[s], d0);
            d1 = MFMA32(mk8(trread(ap + (16 * s + 1) * 512), trread(ap + (16 * s + 1) * 512 + 256)), wf[s], d1);
        }
        const float bs = F.P(P_BSP)[(l * 4 + h) * 128 + 32 * ib + r32];
#pragma unroll
        for (int i = 0; i < 4; ++i) { const int id = lane + 64 * i, row = id >> 3, ch = id & 7; const bf16* hr = H + (size_t)(row0 + 32 * ib + row) * DIN + h * 64 + ch * 8;
            *(LAS v4u*)(stg + row * 144 + ch * 16) = *(const v4u*)(hr + C_AU); *(LAS v4u*)(stg + 4608 + row * 144 + ch * 16) = *(const v4u*)(hr + C_AG); }
#pragma unroll
        for (int a = 0; a < 4; ++a) {
            { LAS u32x2* sp = (LAS u32x2*)(stg + r32 * 144 + (8 * a + 4 * hi) * 2); const u32x2 uw = *sp, gw = *(LAS u32x2*)((LAS unsigned char*)sp + 4608); u32x2 ow;
              ow.x = cvtpk((d0[4 * a + 0] + bs) * gelu_f(bflo(uw.x)) * silu_f(bflo(gw.x)), (d0[4 * a + 1] + bs) * gelu_f(bfhi(uw.x)) * silu_f(bfhi(gw.x)));
              ow.y = cvtpk((d0[4 * a + 2] + bs) * gelu_f(bflo(uw.y)) * silu_f(bflo(gw.y)), (d0[4 * a + 3] + bs) * gelu_f(bfhi(uw.y)) * silu_f(bfhi(gw.y))); *sp = ow; }
            { LAS u32x2* sp = (LAS u32x2*)(stg + r32 * 144 + (32 + 8 * a + 4 * hi) * 2); const u32x2 uw = *sp, gw = *(LAS u32x2*)((LAS unsigned char*)sp + 4608); u32x2 ow;
              ow.x = cvtpk((d1[4 * a + 0] + bs) * gelu_f(bflo(uw.x)) * silu_f(bflo(gw.x)), (d1[4 * a + 1] + bs) * gelu_f(bfhi(uw.x)) * silu_f(bfhi(gw.x)));
              ow.y = cvtpk((d1[4 * a + 2] + bs) * gelu_f(bflo(uw.y)) * silu_f(bflo(gw.y)), (d1[4 * a + 3] + bs) * gelu_f(bfhi(uw.y)) * silu_f(bfhi(gw.y))); *sp = ow; }
        }
#pragma unroll
        for (int i = 0; i < 4; ++i) { const int id = lane + 64 * i, row = id >> 3, ch = id & 7;
            *(v4u*)(F.MIX() + (size_t)(row0 + 32 * ib + row) * DM + h * 64 + ch * 8) = *(const LAS v4u*)(stg + row * 144 + ch * 16); }
    }
    __syncthreads();
}

constexpr int MB_Y = 0, MB_C = 81920;
__device__ __forceinline__ void mixB_unit(const Ctx& Fin, int l, int c, LAS unsigned char* L) {
    const Ctx F = fresh(Fin);
    const int tid = F.tid, lane = F.lane, wave = F.wave;
    const int n = c % CPS; const long row0 = (long)c * CHUNK; const bf16* H = F.H();
#pragma unroll 2
    for (int rr = wave; rr < 158; rr += NWAVES) { const int pos = n * CHUNK - 15 + rr; u32x2 o = {0u, 0u};
        if (pos >= 0 && pos < SEQ) { const bf16* hr = H + (size_t)(row0 - 15 + rr) * DIN + 4 * lane; const u32x2 a = *(const u32x2*)(hr + C_BA), b = *(const u32x2*)(hr + C_BB);
            o.x = cvtpk(bflo(a.x) * sigmoid_f(bflo(b.x)), bfhi(a.x) * sigmoid_f(bfhi(b.x))); o.y = cvtpk(bflo(a.y) * sigmoid_f(bflo(b.y)), bfhi(a.y) * sigmoid_f(bfhi(b.y))); }
        *(LAS u32x2*)(L + MB_Y + rr * 512 + lane * 8) = o; }
    __syncthreads();
    const int ch = tid & 255, half = tid >> 8;
    float w[31]; { const float* cw = F.P(P_CONVW) + (size_t)l * 31 * 256 + ch;
#pragma unroll
        for (int k = 0; k < 31; ++k) w[k] = cw[k * 256]; }
    const float cb = F.P(P_CONVB)[l * 256 + ch];
    const LAS bf16* ys = (const LAS bf16*)(L + MB_Y) + ch;
    LAS float* cs = (LAS float*)(L + MB_C);
    const f32x4 gg = *(const f32x4*)(F.P(P_CONVG) + l * 256 + 4 * lane), bb = *(const f32x4*)(F.P(P_CONVBB) + l * 256 + 4 * lane);
#pragma unroll 1
    for (int blk = 0; blk < 4; ++blk) {
        const int t0 = half * 64 + blk * 16;
        float acc[16];
#pragma unroll
        for (int t = 0; t < 16; ++t) acc[t] = cb;
#pragma unroll
        for (int r = 0; r < 46; ++r) { const float yv = bf2f(ys[(t0 + r) * 256]);
#pragma unroll
            for (int t = 0; t < 16; ++t) { const int k = r - t; if (k >= 0 && k <= 30) acc[t] = fmaf(w[k], yv, acc[t]); } }
#pragma unroll
        for (int t = 0; t < 16; ++t) cs[(half * 16 + t) * 256 + ch] = acc[t];
        __syncthreads();
#pragma unroll
        for (int i = 0; i < 4; ++i) { const int srow = wave * 4 + i, tok = (srow >> 4) * 64 + blk * 16 + (srow & 15);
            f32x4 v = *(const LAS f32x4*)(cs + srow * 256 + 4 * lane);
            const float mean = wave_sum((v.x + v.y) + (v.z + v.w)) * (1.f / 256.f); v = v - mean;
            const float rstd = 1.f / sqrtf(wave_sum((v.x * v.x + v.y * v.y) + (v.z * v.z + v.w * v.w)) * (1.f / 256.f) + LN_EPS);
            const f32x4 y = v * rstd * gg + bb;
            const u32x2 gw = *(const u32x2*)(H + (size_t)(row0 + tok) * DIN + C_BG + 4 * lane); u32x2 o;
            o.x = cvtpk(silu_f(y.x) * silu_f(bflo(gw.x)), silu_f(y.y) * silu_f(bfhi(gw.x))); o.y = cvtpk(silu_f(y.z) * silu_f(bflo(gw.y)), silu_f(y.w) * silu_f(bfhi(gw.y)));
            *(u32x2*)(F.MIX() + (size_t)(row0 + tok) * DM + 256 + 4 * lane) = o; }
        __syncthreads();
    }
}
#ifndef FAST_ATTN
#define FAST_ATTN 1
#endif
#ifndef FAST_A
#define FAST_A 1
#endif
#ifndef FAST_B
#define FAST_B 1
#endif
__global__ void __launch_bounds__(NT, 2) fwd(Args args) {
    extern __shared__ __attribute__((aligned(16))) unsigned char lds[];
    cg::grid_group grid = cg::this_grid();
    Ctx F;
    F.wave = __builtin_amdgcn_readfirstlane(threadIdx.x >> 6); F.lane = 0; F.tid = 0; F.G = gridDim.x; F.bid = blockIdx.x;
    F.ws = args.ws; F.out = args.out;

    { const Ctx P = fresh(F); prologue(P, args, lds); }
    grid.sync();
#pragma unroll 1
    for (int l = 0; l < DEPTH; ++l) {
        {
            pg8::Gemm g{F.XN(), F.WIN() + (size_t)l * DIN * DM, M, DIN, DM}; pg8::StaticOrder S; S.init(M, DIN, F.G, F.bid);
            pg8::EpiBf16<0> E{F.H(), DIN, nullptr, 0, 0, 1.f};
            pg8::gemm_phase<pg8::EpiBf16<0>, pg8::StaticOrder, true, true>((PG8_LAS unsigned char*)lds, g, S, E, F.wave);
        }
        grid.sync();
        {   const Ctx P = fresh(F);
            for (int c = P.bid; c < NCHUNK; c += P.G) {
#if FAST_ATTN
#pragma unroll 1
                for (int kvh = 0; kvh < 2; ++kvh) attn_unit(P, l, c, kvh, (LAS unsigned char*)lds);
#else
                naive_attn(P, l, c, 0, lds); naive_attn(P, l, c, 1, lds);
#endif
#if FAST_A
                mixA_unit(P, l, c, (LAS unsigned char*)lds);
#else
                naive_mixA(P, l, c, lds);
#endif
#if FAST_B
                mixB_unit(P, l, c, (LAS unsigned char*)lds);
#else
                naive_mixB(P, l, c, lds);
#endif
            } }
        grid.sync();
        {
            pg8::Gemm g{F.MIX(), F.WOUT() + (size_t)l * DM * DM, M, DM, DM}; pg8::StaticOrder S; S.init(M, DM, F.G, F.bid);
            pg8::EpiResF32 E{F.out, F.out, DM, ALPHA};
            pg8::gemm_phase<pg8::EpiResF32, pg8::StaticOrder, true, true>((PG8_LAS unsigned char*)lds, g, S, E, F.wave);
        }
        grid.sync();
        { const Ctx P = fresh(F); post_ln(P, l); }
        if (l + 1 < DEPTH) grid.sync();
    }
}

extern "C" void kernel_launch(void* const* d_in, const int* in_sizes, int n_in, void* d_out, int out_size, void* d_ws, size_t ws_size, hipStream_t stream) {
    static int grid = 0;
    if (grid == 0) {
        if (n_in != 17 || out_size != M * DM || ws_size < WS_END) { fprintf(stderr, "kernel_launch: unexpected shapes n_in %d out %d ws %zu\n", n_in, out_size, ws_size); grid = -1; return; }
        int dev = 0, cus = 0, per_cu = 0;
        (void)hipGetDevice(&dev);
        (void)hipDeviceGetAttribute(&cus, hipDeviceAttributeMultiprocessorCount, dev);
        (void)hipFuncSetAttribute((const void*)fwd, hipFuncAttributeMaxDynamicSharedMemorySize, LDS_BYTES);
        (void)hipOccupancyMaxActiveBlocksPerMultiprocessor(&per_cu, (const void*)fwd, NT, LDS_BYTES);
        if (per_cu < 1) fprintf(stderr, "kernel_launch: occupancy query reports %d blocks per CU\n", per_cu);
        grid = cus;
    }
    if (grid < 0) return;
    Args a{};
    for (int i = 0; i < 17; ++i) a.in[i] = (const float*)d_in[i];
    a.out = (float*)d_out; a.ws = (unsigned char*)d_ws;
    void* kargs[] = {&a};
    hipError_t e = hipLaunchCooperativeKernel((void*)fwd, dim3(grid), dim3(NT), kargs, LDS_BYTES, stream);
    if (e != hipSuccess) fprintf(stderr, "cooperative launch failed: %s (grid %d)\n", hipGetErrorString(e), grid);
}
```

```cpp
#include <hip/hip_runtime.h>
#include <hip/hip_cooperative_groups.h>
#include <cstdio>
#include <cstdint>
namespace cg = cooperative_groups;
namespace pg8 {
#define PG8_LAS __attribute__((address_space(3)))
typedef unsigned short bf16_t;
typedef short bf16x8 __attribute__((ext_vector_type(8)));
typedef float f32x4 __attribute__((ext_vector_type(4)));
typedef unsigned u32x4 __attribute__((ext_vector_type(4)));
constexpr int BM = 256, BK = 64, HALF = 128, HTB = HALF * BK * 2  , STAGE_BYTES = 8 * HTB, NXCD = 8, WGM = 8;

__host__ __device__ __forceinline__ int lds_byte(int r, int c) { const int st = (r >> 4) * 2 + (c >> 5), rr = r & 15, cc = c & 31, ob = rr * 64 + cc * 2; return st * 1024 + (ob ^ (((ob >> 9) & 1) << 5)); }
__host__ __device__ __forceinline__ void stage_rc(int b, int& R, int& C) { const int st = b / 1024, sb = b % 1024, swz = sb ^ (((sb >> 9) & 1) << 5); R = (st >> 1) * 16 + swz / 64; C = (st & 1) * 32 + (swz % 64) / 2; }
__host__ __device__ __forceinline__ int perm32(int rho) { const int n = rho >> 4, i = rho & 15; return 8 * (i >> 2) + 4 * n + (i & 3); }

struct Unit { int pm, pn; };
struct Gemm { const bf16_t* A; const bf16_t* Bt; int M, N, K; };

struct StaticOrder {
    int nM, nN, nwg, G, c;
    __host__ __device__ void init(int M, int N, int G_, int c_) { nM = M / BM; nN = N / BM; nwg = nM * nN; G = G_; c = c_; }
    __host__ __device__ bool next(int i, Unit& u) const {
        const long L = (long)i * G + c; if (L >= nwg) return false;
        int wgid = (int)L; { const int q = nwg / NXCD, r = nwg % NXCD, xcd = wgid % NXCD, off = wgid / NXCD; wgid = (xcd < r ? xcd * (q + 1) : r * (q + 1) + (xcd - r) * q) + off; }
        const int nig = WGM * nN, gid = wgid / nig, fm = gid * WGM, gsz = (nM - fm) < WGM ? (nM - fm) : WGM;
        u.pm = fm + ((wgid % nig) % gsz); u.pn = (wgid % nig) / gsz; return true;
    }
    __device__ __forceinline__ void a_ready(const Unit&) const {}
    __device__ __forceinline__ void done(const Unit&) const {}
};

__device__ __forceinline__ unsigned cvt_pk_bf16(float lo, float hi) { unsigned r; asm volatile("v_cvt_pk_bf16_f32 %0, %1, %2" : "=v"(r) : "v"(lo), "v"(hi)); return r; }
typedef float f32x2 __attribute__((ext_vector_type(2)));
__device__ __forceinline__ f32x2 gelu_pk(f32x2 v) {
    const f32x2 av = __builtin_elementwise_abs(v), d = av * 0.2316418882f + 1.0f;
    f32x2 t; t.x = __builtin_amdgcn_rcpf(d.x); t.y = __builtin_amdgcn_rcpf(d.y);
    f32x2 q = t * 0.5307027145f + (-0.7265760135f); q = q * t + 0.7107068705f; q = q * t + (-0.142248368f); q = q * t + 0.127414796f; q = q * t;
    const f32x2 s = (v * v) * (-0.72134752044f);
    f32x2 e; e.x = __builtin_amdgcn_exp2f(s.x); e.y = __builtin_amdgcn_exp2f(s.y);
    const f32x2 m = v * (q * e), r = v - m;
    f32x2 o; o.x = v.x < 0.f ? m.x : r.x; o.y = v.y < 0.f ? m.y : r.y; return o;
}

template <int ACT  > struct EpiBf16 {
    static constexpr bool PERM = true, AFTER_DRAIN = false; static_assert(ACT == 0 || ACT == 1, "EpiBf16: ACT is 0 (none) or 1 (gelu_pk)");
    bf16_t* O; int ldc; const float* bias; int split_cols; size_t split_stride; float scale0;
    __device__ __forceinline__ void operator()(const f32x4 (&acc)[2][2][4][2], const Unit& u, int wr, int wc, int fr, int fq) const {
        const int row0 = u.pm * BM + wr * 64 + fr; int colt = u.pn * BM; bf16_t* base = O;
        float sc = 1.f; if (split_cols) { const int t = colt / split_cols; base += (size_t)t * split_stride; colt -= t * split_cols; if (t == 0) sc = scale0; }
        const int col0 = colt + wc * 32 + 8 * fq, bcol0 = u.pn * BM + wc * 32 + 8 * fq;
        f32x4 bv[2][2];
#pragma unroll
        for (int bj = 0; bj < 2; ++bj)
#pragma unroll
            for (int n = 0; n < 2; ++n) bv[bj][n] = bias ? *(const f32x4*)(bias + bcol0 + bj * HALF + 4 * n) : (f32x4){0.f, 0.f, 0.f, 0.f};
#pragma unroll
        for (int ai = 0; ai < 2; ++ai)
#pragma unroll
            for (int m = 0; m < 4; ++m) { bf16_t* rowp = base + (size_t)(row0 + ai * HALF + m * 16) * ldc + col0;
#pragma unroll
                for (int bj = 0; bj < 2; ++bj) { f32x4 v0 = acc[ai][bj][m][0] + bv[bj][0], v1 = acc[ai][bj][m][1] + bv[bj][1];
                    if (ACT == 1) { f32x2 a = gelu_pk((f32x2){v0[0], v0[1]}), b = gelu_pk((f32x2){v0[2], v0[3]}), c = gelu_pk((f32x2){v1[0], v1[1]}), d = gelu_pk((f32x2){v1[2], v1[3]});
                        v0 = (f32x4){a.x, a.y, b.x, b.y}; v1 = (f32x4){c.x, c.y, d.x, d.y}; }
                    v0 = v0 * sc; v1 = v1 * sc; u32x4 w; w.x = cvt_pk_bf16(v0[0], v0[1]); w.y = cvt_pk_bf16(v0[2], v0[3]); w.z = cvt_pk_bf16(v1[0], v1[1]); w.w = cvt_pk_bf16(v1[2], v1[3]);
                    *(u32x4*)(rowp + bj * HALF) = w; } }
    }
};

struct PanelStats {
    unsigned* xbuf;
    unsigned* cnt;
    unsigned* tmo;
    int ntn; float eps;
    unsigned code;
    __device__ __forceinline__ bool run(const f32x4 (&v)[2][2][4][2], const Unit& u, int wr, int wc, int fr, int fq, PG8_LAS unsigned char* lds, int wid, int lane) const {
        typedef float f32x2v __attribute__((ext_vector_type(2)));
        PG8_LAS f32x2v* P = (PG8_LAS f32x2v*)lds;
        PG8_LAS f32x2v* S = (PG8_LAS f32x2v*)(lds + 8192);
        PG8_LAS unsigned* flag = (PG8_LAS unsigned*)(lds + 8192 + 2048);
#pragma unroll
        for (int ai = 0; ai < 2; ++ai)
#pragma unroll
            for (int m = 0; m < 4; ++m) {
                float s = 0.f;
#pragma unroll
                for (int bj = 0; bj < 2; ++bj)
#pragma unroll
                    for (int n = 0; n < 2; ++n) { const f32x4 x = v[ai][bj][m][n]; s += (x[0] + x[1]) + (x[2] + x[3]); }
                s += __shfl_xor(s, 16); s += __shfl_xor(s, 32);
                const float mw = s * (1.0f / 64.0f); float q = 0.f;
#pragma unroll
                for (int bj = 0; bj < 2; ++bj)
#pragma unroll
                    for (int n = 0; n < 2; ++n) { const f32x4 d = v[ai][bj][m][n] - mw; q += (d[0] * d[0] + d[1] * d[1]) + (d[2] * d[2] + d[3] * d[3]); }
                q += __shfl_xor(q, 16); q += __shfl_xor(q, 32);
                if (fq == 0) P[(ai * HALF + wr * 64 + m * 16 + fr) * 4 + wc] = (f32x2v){mw, q};
            }
        asm volatile("s_waitcnt lgkmcnt(0)" ::: "memory"); __builtin_amdgcn_s_barrier(); asm volatile("" ::: "memory");
#if defined(BROKEN_EXCHANGE_NO_WAIT)
#warning BROKEN CONTROL BUILD: the row-statistics exchange does not wait; results are wrong by design
        if (blockIdx.x >= 64) { const long long t0_ = clock64(); while (clock64() - t0_ < 60000) __builtin_amdgcn_s_sleep(8); }
#endif
        const int row = wid * 32 + (lane & 31);
        if (lane < 32) {
            const f32x2v a = P[row * 4 + 0], b = P[row * 4 + 1], c = P[row * 4 + 2], d = P[row * 4 + 3];
            const float mt = (a.x + b.x + c.x + d.x) * 0.25f;
            const float da = a.x - mt, db = b.x - mt, dc = c.x - mt, dd = d.x - mt;
            const float m2 = (a.y + b.y) + (c.y + d.y) + 64.0f * ((da * da + db * db) + (dc * dc + dd * dd));
            unsigned long long* slot = (unsigned long long*)xbuf + ((size_t)(u.pm * BM + row) * 4 + u.pn);
            __hip_atomic_store(slot, ((unsigned long long)__float_as_uint(m2) << 32) | __float_as_uint(mt), __ATOMIC_RELAXED, __HIP_MEMORY_SCOPE_AGENT);
        }
        asm volatile("s_waitcnt vmcnt(0)" ::: "memory");
        if (lane == 0) __hip_atomic_fetch_add(cnt + 64 * u.pm, 1u, __ATOMIC_RELAXED, __HIP_MEMORY_SCOPE_AGENT);
        if (wid == 0) {
            bool dead = false; const unsigned long long t0 = __builtin_amdgcn_s_memrealtime(); const unsigned want = 8u * (unsigned)ntn;
            for (;;) {
#if defined(BROKEN_EXCHANGE_NO_WAIT)
                break;
#endif
                if ((unsigned)__builtin_amdgcn_readfirstlane(__hip_atomic_load(cnt + 64 * u.pm, __ATOMIC_RELAXED, __HIP_MEMORY_SCOPE_AGENT)) >= want) break;
                if (__builtin_amdgcn_s_memrealtime() - t0 > 2000000ull) {
                    if (lane == 0) { unsigned expect = 0u; __hip_atomic_compare_exchange_strong(tmo + 1, &expect, code | (unsigned)(u.pm & 0xff), __ATOMIC_RELAXED, __ATOMIC_RELAXED, __HIP_MEMORY_SCOPE_AGENT);
                                     __hip_atomic_store(tmo, 1u, __ATOMIC_RELAXED, __HIP_MEMORY_SCOPE_AGENT); }
                    dead = true; break; }
                __builtin_amdgcn_s_sleep(2);
            }
            __builtin_amdgcn_fence(__ATOMIC_ACQUIRE, "agent");
            if (lane == 0) flag[0] = dead ? 1u : 0u;
        }
        asm volatile("s_waitcnt vmcnt(0) lgkmcnt(0)" ::: "memory"); __builtin_amdgcn_s_barrier(); asm volatile("" ::: "memory");
        const bool bad = flag[0] != 0u;
        if (lane < 32) {
            const unsigned long long* slot = (const unsigned long long*)xbuf + (size_t)(u.pm * BM + row) * 4; float mt[4], m2[4]; float ms = 0.f;
#pragma unroll
            for (int t = 0; t < 4; ++t) { if (t < ntn) { const unsigned long long w = __hip_atomic_load(slot + t, __ATOMIC_RELAXED, __HIP_MEMORY_SCOPE_AGENT); mt[t] = __uint_as_float((unsigned)w); m2[t] = __uint_as_float((unsigned)(w >> 32)); } else { mt[t] = 0.f; m2[t] = 0.f; } ms += mt[t]; }
            const float mean = ms / (float)ntn; float q = 0.f;
#pragma unroll
            for (int t = 0; t < 4; ++t) if (t < ntn) { const float dm = mt[t] - mean; q += m2[t] + 256.0f * dm * dm; }
            S[row] = (f32x2v){mean, 1.0f / sqrtf(q / (256.0f * (float)ntn) + eps)};
        }
        asm volatile("s_waitcnt lgkmcnt(0)" ::: "memory"); __builtin_amdgcn_s_barrier(); asm volatile("" ::: "memory");
        return bad;
    }
};
struct EpiLnRes {
    static constexpr bool PERM = false, AFTER_DRAIN = true;
    const float* base; float* out; int ldc; const float* bias; PanelStats st; unsigned poison;
    __device__ __forceinline__ void fused(f32x4 (&acc)[2][2][4][2], const Unit& u, int wr, int wc, int fr, int fq, PG8_LAS unsigned char* lds, int wid, int lane) const {
        typedef float f32x2v __attribute__((ext_vector_type(2)));
        const PG8_LAS f32x2v* S = (const PG8_LAS f32x2v*)(lds + 8192);
        const int col0 = u.pn * BM + wc * 32 + 4 * fq;
#pragma unroll
        for (int bj = 0; bj < 2; ++bj)
#pragma unroll
            for (int n = 0; n < 2; ++n) { const f32x4 bv = bias ? *(const f32x4*)(bias + col0 + bj * HALF + n * 16) : (f32x4){0.f, 0.f, 0.f, 0.f};
#pragma unroll
                for (int ai = 0; ai < 2; ++ai)
#pragma unroll
                    for (int m = 0; m < 4; ++m) acc[ai][bj][m][n] += bv; }
        f32x4 pre[4][2][2];
#pragma unroll
        for (int m = 0; m < 4; ++m) { const size_t off = (size_t)(u.pm * BM + wr * 64 + m * 16 + fr) * ldc + col0;
#pragma unroll
            for (int bj = 0; bj < 2; ++bj)
#pragma unroll
                for (int n = 0; n < 2; ++n) pre[m][bj][n] = *(const f32x4*)(base + off + bj * HALF + n * 16); }
        const bool bad = st.run(acc, u, wr, wc, fr, fq, lds, wid, lane) || poison != 0u;
        const float qnan = __builtin_nanf("");
#pragma unroll
        for (int ai = 0; ai < 2; ++ai)
#pragma unroll
            for (int m = 0; m < 4; ++m) { const int r = ai * HALF + wr * 64 + m * 16 + fr; const f32x2v sr = S[r]; const size_t off = (size_t)(u.pm * BM + r) * ldc + col0;
#pragma unroll
                for (int bj = 0; bj < 2; ++bj)
#pragma unroll
                    for (int n = 0; n < 2; ++n) { const f32x4 bs = ai == 0 ? pre[m][bj][n] : *(const f32x4*)(base + off + bj * HALF + n * 16); f32x4 o = bs + (acc[ai][bj][m][n] - sr.x) * sr.y;
                        if (bad) o = (f32x4){qnan, qnan, qnan, qnan}; *(f32x4*)(out + off + bj * HALF + n * 16) = o; }
                if (m & 1) asm volatile("" ::: "memory"); }
    }
};
struct EpiLnResLn {
    static constexpr bool PERM = false, AFTER_DRAIN = true;
    const float* base; float* out; bf16_t* xn; int ldc; const float* bias; PanelStats st1, st2; unsigned poison;
    __device__ __forceinline__ void fused(f32x4 (&acc)[2][2][4][2], const Unit& u, int wr, int wc, int fr, int fq, PG8_LAS unsigned char* lds, int wid, int lane) const {
        typedef float f32x2v __attribute__((ext_vector_type(2))); typedef unsigned u32x2v __attribute__((ext_vector_type(2)));
        const PG8_LAS f32x2v* S = (const PG8_LAS f32x2v*)(lds + 8192);
        const int col0 = u.pn * BM + wc * 32 + 4 * fq;
#pragma unroll
        for (int bj = 0; bj < 2; ++bj)
#pragma unroll
            for (int n = 0; n < 2; ++n) { const f32x4 bv = bias ? *(const f32x4*)(bias + col0 + bj * HALF + n * 16) : (f32x4){0.f, 0.f, 0.f, 0.f};
#pragma unroll
                for (int ai = 0; ai < 2; ++ai)
#pragma unroll
                    for (int m = 0; m < 4; ++m) acc[ai][bj][m][n] += bv; }
        bool bad = st1.run(acc, u, wr, wc, fr, fq, lds, wid, lane) || poison != 0u;
        const float qnan = __builtin_nanf("");
#pragma unroll
        for (int ai = 0; ai < 2; ++ai)
#pragma unroll
            for (int m = 0; m < 4; ++m) { const int r = ai * HALF + wr * 64 + m * 16 + fr; const f32x2v sr = S[r]; const size_t off = (size_t)(u.pm * BM + r) * ldc + col0;
#pragma unroll
                for (int bj = 0; bj < 2; ++bj)
#pragma unroll
                    for (int n = 0; n < 2; ++n) { const f32x4 bs = *(const f32x4*)(base + off + bj * HALF + n * 16); acc[ai][bj][m][n] = bs + (acc[ai][bj][m][n] - sr.x) * sr.y; }
                asm volatile("" : "+v"(acc[ai][0][m][0]), "+v"(acc[ai][0][m][1]), "+v"(acc[ai][1][m][0]), "+v"(acc[ai][1][m][1]));
                if (m & 1) asm volatile("" ::: "memory"); }
        const bool bad1 = bad;
        bad = st2.run(acc, u, wr, wc, fr, fq, lds, wid, lane) || bad;
#pragma unroll
        for (int ai = 0; ai < 2; ++ai)
#pragma unroll
            for (int m = 0; m < 4; ++m) { const int r = ai * HALF + wr * 64 + m * 16 + fr; const f32x2v sr = S[r]; const size_t off = (size_t)(u.pm * BM + r) * ldc + col0;
#pragma unroll
                for (int bj = 0; bj < 2; ++bj)
#pragma unroll
                    for (int n = 0; n < 2; ++n) { const f32x4 x1 = acc[ai][bj][m][n]; *(f32x4*)(out + off + bj * HALF + n * 16) = bad1 ? (f32x4){qnan, qnan, qnan, qnan} : x1;
                        const f32x4 o = (x1 - sr.x) * sr.y; u32x2v w; w.x = cvt_pk_bf16(o[0], o[1]); w.y = cvt_pk_bf16(o[2], o[3]);
                        if (bad) { w.x = 0x7fc07fc0u; w.y = 0x7fc07fc0u; } *(u32x2v*)(xn + off + bj * HALF + n * 16) = w; }
                asm volatile("" ::: "memory"); }
    }
};

template <class Epi, class Sched, bool ALIGN_EPI = false, bool SP2 = false>
__device__ __forceinline__ void gemm_phase(PG8_LAS unsigned char* lds, const Gemm g, const Sched& S, const Epi& E, int wave_in) {
    int lane_; asm volatile("v_mbcnt_lo_u32_b32 %0, -1, 0\n\tv_mbcnt_hi_u32_b32 %0, -1, %0" : "=v"(lane_));
    int wid_ = wave_in; asm volatile("" : "+s"(wid_));
    const int wid = wid_, lane = lane_, tid = wid * 64 + lane, wr = wid >> 2, wc = wid & 3, fr = lane & 15, fq = lane >> 4;
    const int K = g.K, nt = K / BK;
    unsigned voffA[2], voffB[2];
#pragma unroll
    for (int i = 0; i < 2; ++i) { int R, C; stage_rc(tid * 16 + i * 8192, R, C); const int Rb = Epi::PERM ? ((R & ~31) + perm32(R & 31)) : R;
        voffA[i] = (unsigned)(R * K + C) * 2u; voffB[i] = (unsigned)(Rb * K + C) * 2u; }
    const size_t kstep = (size_t)(BK * 2);
    const size_t hstep = (size_t)HALF * K * 2;
    const size_t tstep = 2 * hstep;
    const unsigned ldsw = (unsigned)wid * 1024u;
    const int aoff = lds_byte(wr * 64 + fr, fq * 8), boff = lds_byte(wc * 32 + fr, fq * 8);
#define PG8_SA(b, h) (((b) * 2 + (h)) * HTB)
#define PG8_SB(b, h) ((4 + (b) * 2 + (h)) * HTB)
#define PG8_STAGE(bufoff, gbase, voff) do { _Pragma("unroll") for (int _i = 0; _i < 2; ++_i) \
        __builtin_amdgcn_global_load_lds((const unsigned*)((const char*)(gbase) + (voff)[_i]), (PG8_LAS unsigned*)(lds + (bufoff) + ldsw + _i * 8192), 16, 0, 0); } while (0)
#define PG8_LDA(dst, b, h) do { _Pragma("unroll") for (int m = 0; m < 4; ++m) _Pragma("unroll") for (int k = 0; k < 2; ++k) dst[m][k] = *(const PG8_LAS bf16x8*)(lds + PG8_SA(b, h) + aoff + m * 2048 + k * 1024); } while (0)
#define PG8_LDB(dst, b, h) do { _Pragma("unroll") for (int n = 0; n < 2; ++n) _Pragma("unroll") for (int k = 0; k < 2; ++k) dst[n][k] = *(const PG8_LAS bf16x8*)(lds + PG8_SB(b, h) + boff + n * 2048 + k * 1024); } while (0)
#define PG8_MMA(ai, bj, At, Bt) do { __builtin_amdgcn_s_setprio(1); _Pragma("unroll") for (int m = 0; m < 4; ++m) _Pragma("unroll") for (int n = 0; n < 2; ++n) _Pragma("unroll") for (int k = 0; k < 2; ++k) \
        acc[ai][bj][m][n] = __builtin_amdgcn_mfma_f32_16x16x32_bf16(Bt[n][k], At[m][k], acc[ai][bj][m][n], 0, 0, 0); __builtin_amdgcn_s_setprio(0); } while (0)
#define PG8_WAIT_V(n) asm volatile("s_waitcnt vmcnt(" #n ")" ::: "memory")
#define PG8_WAIT_L(n) asm volatile("s_waitcnt lgkmcnt(" #n ")" ::: "memory")
#define PG8_BAR __builtin_amdgcn_s_barrier()
#define PG8_SCHED __builtin_amdgcn_sched_barrier(0)
    Unit cur, nxt; int ui = 0;
    if (!S.next(0, cur)) return;
    f32x4 acc[2][2][4][2];
#pragma unroll
    for (int a = 0; a < 2; ++a)
#pragma unroll
        for (int b = 0; b < 2; ++b)
#pragma unroll
            for (int m = 0; m < 4; ++m)
#pragma unroll
                for (int n = 0; n < 2; ++n) acc[a][b][m][n] = (f32x4){0.f, 0.f, 0.f, 0.f};
    bf16x8 At[4][2], B0[2][2], B1[2][2];
    const char* cA = (const char*)g.A + (size_t)cur.pm * tstep; const char* cB = (const char*)g.Bt + (size_t)cur.pn * tstep;
    S.a_ready(cur);
    if constexpr (SP2) {
        PG8_STAGE(PG8_SB(0, 0), cB, voffB); PG8_STAGE(PG8_SB(0, 1), cB + hstep, voffB); PG8_STAGE(PG8_SA(0, 0), cA, voffA); PG8_STAGE(PG8_SA(0, 1), cA + hstep, voffA);
        if (wr == 1) PG8_BAR;
        PG8_WAIT_V(2); PG8_BAR;
        PG8_STAGE(PG8_SB(1, 0), cB + kstep, voffB); PG8_STAGE(PG8_SA(1, 0), cA + kstep, voffA); PG8_STAGE(PG8_SB(1, 1), cB + hstep + kstep, voffB);
        PG8_WAIT_V(6); PG8_BAR;
    } else {
        PG8_STAGE(PG8_SB(0, 0), cB, voffB); PG8_STAGE(PG8_SA(0, 0), cA, voffA); PG8_STAGE(PG8_SB(0, 1), cB + hstep, voffB); PG8_STAGE(PG8_SA(0, 1), cA + hstep, voffA);
        if (wr == 1) PG8_BAR;
        PG8_WAIT_V(4); PG8_BAR;
        PG8_STAGE(PG8_SB(1, 0), cB + kstep, voffB); PG8_STAGE(PG8_SA(1, 0), cA + kstep, voffA); PG8_STAGE(PG8_SB(1, 1), cB + hstep + kstep, voffB);
        PG8_WAIT_V(6); PG8_BAR;
    }
    for (;;) {
        const bool has_next = S.next(ui + 1, nxt);
        const char* nA = has_next ? (const char*)g.A + (size_t)nxt.pm * tstep : cA; const char* nB = has_next ? (const char*)g.Bt + (size_t)nxt.pn * tstep : cB;
        for (int t = 0; t < nt; t += 2) {
            const bool last = (t == nt - 2);
            const char* a1 = cA + (size_t)(t + 1) * kstep;
            const char* a2 = last ? nA : cA + (size_t)(t + 2) * kstep; const char* b2 = last ? nB : cB + (size_t)(t + 2) * kstep;
            const char* a3 = a2 + kstep; const char* b3 = b2 + kstep;
            if (last && has_next) S.a_ready(nxt);
            if constexpr (SP2) {
            PG8_LDB(B0, 0, 0); PG8_LDB(B1, 0, 1); PG8_SCHED; PG8_LDA(At, 0, 0); PG8_STAGE(PG8_SA(1, 1), a1 + hstep, voffA);
            PG8_WAIT_V(8); PG8_WAIT_L(0); PG8_BAR; PG8_MMA(0, 0, At, B0); PG8_MMA(0, 1, At, B1); PG8_BAR; PG8_SCHED;
            PG8_LDA(At, 0, 1); PG8_STAGE(PG8_SB(0, 0), b2, voffB); PG8_STAGE(PG8_SB(0, 1), b2 + hstep, voffB); PG8_STAGE(PG8_SA(0, 0), a2, voffA);
            PG8_WAIT_V(8); PG8_WAIT_L(0); PG8_BAR; PG8_MMA(1, 0, At, B0); PG8_MMA(1, 1, At, B1); PG8_BAR; PG8_SCHED;
            PG8_LDB(B0, 1, 0); PG8_LDB(B1, 1, 1); PG8_SCHED; PG8_LDA(At, 1, 0); PG8_STAGE(PG8_SA(0, 1), a2 + hstep, voffA);
            PG8_WAIT_V(8); PG8_WAIT_L(0); PG8_BAR; PG8_MMA(0, 0, At, B0); PG8_MMA(0, 1, At, B1); PG8_BAR; PG8_SCHED;
            PG8_LDA(At, 1, 1); PG8_STAGE(PG8_SB(1, 0), b3, voffB); PG8_STAGE(PG8_SB(1, 1), b3 + hstep, voffB); PG8_STAGE(PG8_SA(1, 0), a3, voffA);
            PG8_WAIT_V(8); PG8_WAIT_L(0); PG8_BAR; PG8_MMA(1, 0, At, B0); PG8_MMA(1, 1, At, B1); PG8_BAR; PG8_SCHED;
            } else {
            PG8_LDB(B0, 0, 0); PG8_SCHED; PG8_LDA(At, 0, 0); PG8_STAGE(PG8_SA(1, 1), a1 + hstep, voffA);
            PG8_WAIT_L(8); PG8_BAR; PG8_WAIT_L(0); PG8_MMA(0, 0, At, B0); PG8_BAR; PG8_SCHED;
            PG8_LDB(B1, 0, 1); PG8_STAGE(PG8_SB(0, 0), b2, voffB);
            PG8_BAR; PG8_WAIT_L(0); PG8_MMA(0, 1, At, B1); PG8_BAR;
            PG8_LDA(At, 0, 1); PG8_STAGE(PG8_SA(0, 0), a2, voffA);
            PG8_BAR; PG8_WAIT_L(0); PG8_MMA(1, 0, At, B0); PG8_BAR; PG8_SCHED;
            PG8_STAGE(PG8_SB(0, 1), b2 + hstep, voffB);
            PG8_WAIT_V(6); PG8_BAR; PG8_MMA(1, 1, At, B1); PG8_BAR;
            PG8_LDB(B0, 1, 0); PG8_SCHED; PG8_LDA(At, 1, 0); PG8_STAGE(PG8_SA(0, 1), a2 + hstep, voffA);
            PG8_WAIT_L(8); PG8_BAR; PG8_WAIT_L(0); PG8_MMA(0, 0, At, B0); PG8_BAR; PG8_SCHED;
            PG8_LDB(B1, 1, 1); PG8_STAGE(PG8_SB(1, 0), b3, voffB);
            PG8_BAR; PG8_WAIT_L(0); PG8_MMA(0, 1, At, B1); PG8_BAR;
            PG8_LDA(At, 1, 1); PG8_STAGE(PG8_SA(1, 0), a3, voffA);
            PG8_BAR; PG8_WAIT_L(0); PG8_MMA(1, 0, At, B0); PG8_BAR; PG8_SCHED;
            PG8_STAGE(PG8_SB(1, 1), b3 + hstep, voffB);
            PG8_WAIT_V(6); PG8_BAR; PG8_MMA(1, 1, At, B1); PG8_BAR;
            }
        }
        if constexpr (ALIGN_EPI) { if (wr == 0) PG8_BAR; }
        if constexpr (!Epi::AFTER_DRAIN) { E(acc, cur, wr, wc, fr, fq); S.done(cur); }
        if (!has_next) break;
#pragma unroll
        for (int a = 0; a < 2; ++a)
#pragma unroll
            for (int b = 0; b < 2; ++b)
#pragma unroll
                for (int m = 0; m < 4; ++m)
#pragma unroll
                    for (int n = 0; n < 2; ++n) acc[a][b][m][n] = (f32x4){0.f, 0.f, 0.f, 0.f};
        cur = nxt; cA = nA; cB = nB; ++ui;
        if constexpr (ALIGN_EPI) { if (wr == 1) PG8_BAR; }
    }
    PG8_WAIT_V(0);
    if constexpr (!ALIGN_EPI) { if (wr == 0) PG8_BAR; }
    PG8_BAR;
    if constexpr (Epi::AFTER_DRAIN) { E.fused(acc, cur, wr, wc, fr, fq, lds, wid, lane); S.done(cur); }
#undef PG8_SA
#undef PG8_SB
#undef PG8_STAGE
#undef PG8_LDA
#undef PG8_LDB
#undef PG8_MMA
#undef PG8_WAIT_V
#undef PG8_WAIT_L
#undef PG8_BAR
#undef PG8_SCHED
}
}

namespace pg8 {
struct EpiResF32 {
    static constexpr bool PERM = false, AFTER_DRAIN = false;
    const float* base; float* out; int ldc; float alpha;
    __device__ __forceinline__ void operator()(const f32x4 (&acc)[2][2][4][2], const Unit& u, int wr, int wc, int fr, int fq) const {
        const int row0 = u.pm * BM + wr * 64 + fr, col0 = u.pn * BM + wc * 32 + 4 * fq;
#pragma unroll
        for (int ai = 0; ai < 2; ++ai)
#pragma unroll
            for (int m = 0; m < 4; ++m) { const size_t off = (size_t)(row0 + ai * HALF + m * 16) * ldc + col0;
#pragma unroll
                for (int bj = 0; bj < 2; ++bj)
#pragma unroll
                    for (int n = 0; n < 2; ++n) { const f32x4 bs = *(const f32x4*)(base + off + bj * HALF + n * 16);
                        *(f32x4*)(out + off + bj * HALF + n * 16) = bs * alpha + acc[ai][bj][m][n]; } }
    }
};
}

constexpr int BATCH = 2, SEQ = 16384, DM = 1024, M = BATCH * SEQ, DIN = 2816, DEPTH = 2;
constexpr int CHUNK = 128, NCHUNK = M / CHUNK, CPS = SEQ / CHUNK;
constexpr int C_AU = 0, C_AV = 256, C_AG = 512, C_BA = 768, C_BB = 1024, C_BG = 1280, C_Q = 1536, C_K = 2048, C_V = 2176, C_CG = 2304;
constexpr float LN_EPS = 1e-5f;
constexpr float ALPHA = 1.4142135623730951f;
constexpr int NWAVES = 8, NT = 512;
constexpr int LDS_BYTES = 147456;
constexpr size_t MiB = 1u << 20;
constexpr size_t WS_WIN = 0;
constexpr size_t WS_WOUT = 12 * MiB;
constexpr size_t WS_CTL = 16 * MiB, CTL_BYTES = 65536;
constexpr int LDS_BAR_OFF = LDS_BYTES - 64;
constexpr size_t WS_BIAS = 17 * MiB;
constexpr size_t WS_XN = 32 * MiB;
constexpr size_t WS_H = 96 * MiB;
constexpr size_t WS_MIX = 272 * MiB;
constexpr size_t WS_END = 336 * MiB;
constexpr size_t WS_WSPB = 17 * MiB + 65536;
constexpr size_t WS_PAR = 18 * MiB;
constexpr int P_GMLP_G = 0, P_GMLP_B = 512, P_BSP = 1024, P_CONVB = 2048, P_CONVG = 2560, P_CONVBB = 3072, P_SINK = 3584, P_POSTG = 4096, P_POSTB = 6144, P_CONVW = 8192, P_WSP = 24576, P_END = 24576 + 131072;

typedef unsigned short bf16;
typedef float f32x4 __attribute__((ext_vector_type(4)));
typedef unsigned v4u __attribute__((ext_vector_type(4)));
#define LAS __attribute__((address_space(3)))

__device__ __forceinline__ float bf2f(unsigned short b) { return __uint_as_float((unsigned)b << 16); }
__device__ __forceinline__ float bflo(unsigned w) { return __uint_as_float(w << 16); }
__device__ __forceinline__ float bfhi(unsigned w) { return __uint_as_float(w & 0xffff0000u); }
__device__ __forceinline__ unsigned f2bf(float f) { unsigned u = __float_as_uint(f); return (u + 0x7fffu + ((u >> 16) & 1u)) >> 16; }
__device__ __forceinline__ unsigned pk2(float lo, float hi) { return f2bf(lo) | (f2bf(hi) << 16); }
__device__ __forceinline__ float sigmoid_f(float x) { return 1.f / (1.f + __expf(-x)); }
__device__ __forceinline__ float silu_f(float x) { return x / (1.f + __expf(-x)); }
__device__ __forceinline__ float gelu_f(float x) { const float u = 0.7978845608028654f * (x + 0.044715f * x * x * x); return x / (1.f + __expf(-2.f * u)); }
#define DPP_XADD(v, ctrl) ((v) + __builtin_bit_cast(float, __builtin_amdgcn_update_dpp(0, __builtin_bit_cast(int, (v)), (ctrl), 0xf, 0xf, true)))
__device__ __forceinline__ float wave_sum(float v) {
    v = DPP_XADD(v, 0xB1);
    v = DPP_XADD(v, 0x4E);
    v = DPP_XADD(v, 0x141);
    v = DPP_XADD(v, 0x140);
    v += __builtin_bit_cast(float, __builtin_amdgcn_ds_swizzle(__builtin_bit_cast(int, v), (16 << 10) | 0x1f));
    auto rr = __builtin_amdgcn_permlane32_swap(__float_as_uint(v), __float_as_uint(v), false, false);
    return __uint_as_float(rr[0]) + __uint_as_float(rr[1]);
}
__device__ __forceinline__ int t5_bucket(int rel) {
    const int n = rel < 0 ? -rel : rel;
    const int b = n < 8 ? n : n < 12 ? 8 : n < 16 ? 9 : n < 23 ? 10 : n < 32 ? 11 : n < 46 ? 12 : n < 64 ? 13 : n < 91 ? 14 : 15;
    return b + (rel > 0 ? 16 : 0);
}

struct Args { const float* in[17]; float* out; unsigned char* ws; };

struct Ctx {
    int tid, lane, wave, G, bid;
    unsigned char* ws; float* out;
    __device__ __forceinline__ bf16* WIN() const { return (bf16*)(ws + WS_WIN); }
    __device__ __forceinline__ bf16* WOUT() const { return (bf16*)(ws + WS_WOUT); }
    __device__ __forceinline__ bf16* XN() const { return (bf16*)(ws + WS_XN); }
    __device__ __forceinline__ bf16* H() const { return (bf16*)(ws + WS_H); }
    __device__ __forceinline__ bf16* MIX() const { return (bf16*)(ws + WS_MIX); }
    __device__ __forceinline__ float* BIAS() const { return (float*)(ws + WS_BIAS); }
    __device__ __forceinline__ const float* P(int off) const { return (const float*)(ws + WS_PAR) + off; }
};

__device__ __forceinline__ int lane_id_now() { int l; asm volatile("v_mbcnt_lo_u32_b32 %0, -1, 0\n\tv_mbcnt_hi_u32_b32 %0, -1, %0" : "=v"(l)); return l; }
__device__ __forceinline__ Ctx fresh(const Ctx& F) {
    Ctx C = F; asm volatile("" : "+s"(C.wave), "+s"(C.ws), "+s"(C.out), "+s"(C.bid), "+s"(C.G));
    C.lane = lane_id_now(); C.tid = C.wave * 64 + C.lane; return C;
}
__device__ __forceinline__ void p0_transpose_item(const float* W, int K, int N, bf16* WT, LAS float* scr, int item, int lane) {
    const int nblk = N / 32, kb = item / nblk, nb = item % nblk, k0 = 64 * kb, n0 = 32 * nb;
#pragma unroll 8
    for (int i = 0; i < 32; ++i) { const int kk = 2 * i + (lane >> 5); scr[kk * 33 + (lane & 31)] = W[(size_t)(k0 + kk) * N + n0 + (lane & 31)]; }
    asm volatile("s_waitcnt lgkmcnt(0)" ::: "memory");
    const int c = lane & 7;
#pragma unroll
    for (int j = 0; j < 4; ++j) { const int n = (lane >> 3) + 8 * j; const LAS float* s = scr + (8 * c) * 33 + n;
        v4u o; o.x = pk2(s[0 * 33], s[1 * 33]); o.y = pk2(s[2 * 33], s[3 * 33]); o.z = pk2(s[4 * 33], s[5 * 33]); o.w = pk2(s[6 * 33], s[7 * 33]);
        *(v4u*)(WT + (size_t)(n0 + n) * K + k0 + 8 * c) = o; }
    asm volatile("s_waitcnt lgkmcnt(0)" ::: "memory");
}
__device__ __forceinline__ void ln_row(const float* xrow, const float* g, const float* b, float* orow, bf16* brow, int lane) {
    const f32x4* xr = (const f32x4*)xrow + lane;
    f32x4 v[4]; float s = 0.f;
#pragma unroll
    for (int j = 0; j < 4; ++j) { v[j] = xr[64 * j]; s += (v[j].x + v[j].y) + (v[j].z + v[j].w); }
    const float mean = wave_sum(s) * (1.f / DM); float s2 = 0.f;
#pragma unroll
    for (int j = 0; j < 4; ++j) { v[j] = v[j] - mean; s2 += (v[j].x * v[j].x + v[j].y * v[j].y) + (v[j].z * v[j].z + v[j].w * v[j].w); }
    const float rstd = 1.f / sqrtf(wave_sum(s2) * (1.f / DM) + LN_EPS);
    f32x4* o4 = (f32x4*)orow + lane; unsigned long long* o8 = (unsigned long long*)brow + lane;
#pragma unroll
    for (int j = 0; j < 4; ++j) { const f32x4 gg = ((const f32x4*)g)[lane + 64 * j], bb = ((const f32x4*)b)[lane + 64 * j];
        const f32x4 y = v[j] * rstd * gg + bb; o4[64 * j] = y;
        o8[64 * j] = (unsigned long long)pk2(y.x, y.y) | ((unsigned long long)pk2(y.z, y.w) << 32); }
}
__device__ __forceinline__ void prologue(const Ctx& F, const Args& A, unsigned char* lds) {
    LAS float* scr = (LAS float*)((LAS unsigned char*)lds + F.wave * 16384);
    const int gw = F.bid * NWAVES + F.wave, NGW = F.G * NWAVES;
    constexpr int I_IN = (DM / 64) * (DIN / 32), I_OUT = (DM / 64) * (DM / 32);
    constexpr int NITEMS = DEPTH * (I_IN + I_OUT);
    for (int it = gw; it < NITEMS; it += NGW) {
        int r = it; const int l = r / (I_IN + I_OUT); r -= l * (I_IN + I_OUT);
        if (r < I_IN) p0_transpose_item(A.in[3] + (size_t)l * DM * DIN, DM, DIN, F.WIN() + (size_t)l * DIN * DM, scr, r, F.lane);
        else p0_transpose_item(A.in[14] + (size_t)l * DM * DM, DM, DM, F.WOUT() + (size_t)l * DM * DM, scr, r - I_IN, F.lane);
    }
    for (int m = gw; m < M; m += NGW) ln_row(A.in[0] + (size_t)m * DM, A.in[1], A.in[2], F.out + (size_t)m * DM, F.XN() + (size_t)m * DM, F.lane);
    if (F.bid == 0) for (int i = F.tid; i < 8 * 257; i += NT) { const int h = i / 257, rel = i % 257 - 128; F.BIAS()[i] = A.in[13][t5_bucket(rel) * 8 + h]; }
    {
        float* P = (float*)(F.ws + WS_PAR); const int gt = F.bid * NT + F.tid, GT = F.G * NT;
        for (int i = gt; i < 512; i += GT) { P[P_GMLP_G + i] = A.in[4][i]; P[P_GMLP_B + i] = A.in[5][i]; P[P_CONVB + i] = A.in[9][i]; P[P_CONVG + i] = A.in[10][i]; P[P_CONVBB + i] = A.in[11][i]; }
        for (int i = gt; i < 1024; i += GT) P[P_BSP + i] = A.in[7][i];
        for (int i = gt; i < 16; i += GT) P[P_SINK + i] = A.in[12][i];
        for (int i = gt; i < 2048; i += GT) { P[P_POSTG + i] = A.in[15][i]; P[P_POSTB + i] = A.in[16][i]; }
        for (int i = gt; i < 2 * 31 * 256; i += GT) P[P_CONVW + i] = A.in[8][i];
        for (int i = gt; i < 2 * 4 * 128 * 128; i += GT) { const float wv = A.in[6][i]; P[P_WSP + i] = wv; ((bf16*)(F.ws + WS_WSPB))[i] = (bf16)f2bf(wv); }
    }
}
__device__ __forceinline__ void post_ln(const Ctx& F, int l, float* of32, bf16* obf) {
    const int gw = F.bid * NWAVES + F.wave, NGW = F.G * NWAVES;
    for (int m = gw; m < M; m += NGW) ln_row(F.out + (size_t)m * DM, F.P(P_POSTG) + l * DM, F.P(P_POSTB) + l * DM, of32 + (size_t)m * DM, obf + (size_t)m * DM, F.lane);
}

__device__ __forceinline__ void naive_attn(const Ctx& F, int l, int c, int kvh, unsigned char* lds) {
    const int tid = F.tid;
    bf16* Ks = (bf16*)lds; bf16* Vs = Ks + 384 * 66;
    const int n = c % CPS; const long row0 = (long)c * CHUNK;
#pragma unroll 2
    for (int idx = tid; idx < 384 * 32; idx += NT) {
        const int r = idx >> 5, cp = idx & 31, pos = n * CHUNK - CHUNK + r; unsigned kv = 0u, vv = 0u;
        if (pos >= 0 && pos < SEQ) { const bf16* hr = F.H() + (size_t)(row0 - CHUNK + r) * DIN; kv = *(const unsigned*)(hr + C_K + kvh * 64 + cp * 2); vv = *(const unsigned*)(hr + C_V + kvh * 64 + cp * 2); }
        *(unsigned*)(Ks + r * 66 + cp * 2) = kv; *(unsigned*)(Vs + r * 66 + cp * 2) = vv;
    }
    __syncthreads();
    const int g = tid >> 7, ti = tid & 127, hq = kvh * 4 + g;
    const bf16* qrow = F.H() + (size_t)(row0 + ti) * DIN + C_Q + hq * 64;
    float q[64], o[64];
#pragma unroll
    for (int d = 0; d < 64; ++d) { q[d] = bf2f(qrow[d]) * 0.125f; o[d] = 0.f; }
    float m = F.P(P_SINK)[l * 8 + hq], lsum = 1.f;
    const float* bt = F.BIAS() + hq * 257;
#pragma unroll 1
    for (int j = 0; j <= 256; ++j) {
        const int k = ti + j, pos = n * CHUNK - CHUNK + k;
        if (pos < 0 || pos >= SEQ) continue;
        float s = 0.f; const unsigned* kr = (const unsigned*)(Ks + k * 66);
#pragma unroll
        for (int dp = 0; dp < 32; ++dp) { const unsigned w = kr[dp]; s += q[2 * dp] * bflo(w) + q[2 * dp + 1] * bfhi(w); }
        s += bt[j];
        if (s > m) { const float f = __expf(m - s); lsum *= f;
#pragma unroll
            for (int d = 0; d < 64; ++d) o[d] *= f;
            m = s; }
        const float p = __expf(s - m); lsum += p;
        const unsigned* vr = (const unsigned*)(Vs + k * 66);
#pragma unroll
        for (int dp = 0; dp < 32; ++dp) { const unsigned w = vr[dp]; o[2 * dp] += p * bflo(w); o[2 * dp + 1] += p * bfhi(w); }
    }
    const float inv = 1.f / lsum;
    const bf16* grow = F.H() + (size_t)(row0 + ti) * DIN + C_CG + hq * 64;
    bf16* orow = F.MIX() + (size_t)(row0 + ti) * DM + 512 + hq * 64;
#pragma unroll
    for (int d = 0; d < 64; d += 2) { const unsigned gw_ = *(const unsigned*)(grow + d);
        *(unsigned*)(orow + d) = pk2(o[d] * inv * silu_f(bflo(gw_)), o[d + 1] * inv * silu_f(bfhi(gw_))); }
    __syncthreads();
}
__device__ __forceinline__ void naive_mixA(const Ctx& F, int l, int c, unsigned char* lds) {
    float* vn = (float*)lds;
    const long row0 = (long)c * CHUNK; const int lane = F.lane;
#pragma unroll 1
    for (int tt = 0; tt < 16; ++tt) {
        const int t = F.wave * 16 + tt; const bf16* hr = F.H() + (size_t)(row0 + t) * DIN + C_AV + 4 * lane;
        float v[4]; float s = 0.f;
#pragma unroll
        for (int i = 0; i < 4; ++i) { v[i] = gelu_f(bf2f(hr[i])); s += v[i]; }
        const float mean = wave_sum(s) * (1.f / 256.f); float s2 = 0.f;
#pragma unroll
        for (int i = 0; i < 4; ++i) { v[i] -= mean; s2 += v[i] * v[i]; }
        const float rstd = 1.f / sqrtf(wave_sum(s2) * (1.f / 256.f) + LN_EPS);
#pragma unroll
        for (int i = 0; i < 4; ++i) vn[t * 256 + 4 * lane + i] = v[i] * rstd * F.P(P_GMLP_G)[l * 256 + 4 * lane + i] + F.P(P_GMLP_B)[l * 256 + 4 * lane + i];
    }
    __syncthreads();
    const int col = F.tid & 255, ih = F.tid >> 8, h = col >> 6;
    const float* W = F.P(P_WSP) + (size_t)(l * 4 + h) * 128 * 128;
#pragma unroll 1
    for (int ii = 0; ii < 64; ++ii) {
        const int i = ih * 64 + ii; const float* wr = W + i * 128; float acc = 0.f;
#pragma unroll 8
        for (int j = 0; j < 128; ++j) acc += wr[j] * vn[j * 256 + col];
        acc += F.P(P_BSP)[(l * 4 + h) * 128 + i];
        const bf16* hr = F.H() + (size_t)(row0 + i) * DIN;
        const float u = gelu_f(bf2f(hr[C_AU + col])), gt = silu_f(bf2f(hr[C_AG + col]));
        F.MIX()[(size_t)(row0 + i) * DM + col] = (bf16)f2bf(acc * u * gt);
    }
    __syncthreads();
}
__device__ __forceinline__ void naive_mixB(const Ctx& F, int l, int c, unsigned char* lds) {
    float* ys = (float*)lds;
    float* co = ys + 62 * 256;
    const int b = c / CPS, n = c % CPS, lane = F.lane;
#pragma unroll 1
    for (int sub = 0; sub < 4; ++sub) {
        const int p0 = n * CHUNK + sub * 32; const long grow0 = (long)b * SEQ + p0;
#pragma unroll 2
        for (int idx = F.tid; idx < 62 * 256; idx += NT) {
            const int r = idx >> 8, col = idx & 255, pos = p0 - 15 + r; float y = 0.f;
            if (pos >= 0 && pos < SEQ) { const bf16* hr = F.H() + (size_t)(grow0 - 15 + r) * DIN; y = bf2f(hr[C_BA + col]) * sigmoid_f(bf2f(hr[C_BB + col])); }
            ys[idx] = y;
        }
        __syncthreads();
        { const int col = F.tid & 255, th = F.tid >> 8; const float* cw = F.P(P_CONVW) + (size_t)l * 31 * 256 + col; const float cb = F.P(P_CONVB)[l * 256 + col];
#pragma unroll 1
          for (int tt = 0; tt < 16; ++tt) { const int t = th * 16 + tt; float acc = cb;
#pragma unroll 8
              for (int k = 0; k < 31; ++k) acc += cw[k * 256] * ys[(t + k) * 256 + col];
              co[t * 256 + col] = acc; } }
        __syncthreads();
#pragma unroll 1
        for (int tt = 0; tt < 4; ++tt) {
            const int t = F.wave * 4 + tt; float v[4]; float s = 0.f;
#pragma unroll
            for (int i = 0; i < 4; ++i) { v[i] = co[t * 256 + 4 * lane + i]; s += v[i]; }
            const float mean = wave_sum(s) * (1.f / 256.f); float s2 = 0.f;
#pragma unroll
            for (int i = 0; i < 4; ++i) { v[i] -= mean; s2 += v[i] * v[i]; }
            const float rstd = 1.f / sqrtf(wave_sum(s2) * (1.f / 256.f) + LN_EPS);
            const bf16* hr = F.H() + (size_t)(grow0 + t) * DIN + C_BG + 4 * lane;
            bf16* orow = F.MIX() + (size_t)(grow0 + t) * DM + 256 + 4 * lane;
#pragma unroll
            for (int i = 0; i < 4; ++i) { const float y = v[i] * rstd * F.P(P_CONVG)[l * 256 + 4 * lane + i] + F.P(P_CONVBB)[l * 256 + 4 * lane + i];
                orow[i] = (bf16)f2bf(silu_f(y) * silu_f(bf2f(hr[i]))); }
        }
        __syncthreads();
    }
}

#define GAS __attribute__((address_space(1)))
typedef GAS unsigned gu32;
typedef GAS unsigned long long gu64;
#define RLX_AGENT __ATOMIC_RELAXED, __HIP_MEMORY_SCOPE_AGENT
#define XB_TMO      128
#define XB_XCNT(j)  (256  + 64 * (j))
#define XB_XSUB(j)  (1280 + 64 * (j))
#define XB_XGEN(j)  (2304 + 64 * (j))
#define XB_TOP      3328
#define XB_TOPGEN   3392
#define XCD_BAR_WORDS 3456
#define XB_SPIN_CAP (1u << 18)

__device__ __forceinline__ unsigned xb_ld(unsigned* p)              { return __hip_atomic_load(p, __ATOMIC_RELAXED, __HIP_MEMORY_SCOPE_AGENT); }
__device__ __forceinline__ unsigned xb_add(unsigned* p, unsigned v) { return __hip_atomic_fetch_add(p, v, __ATOMIC_RELAXED, __HIP_MEMORY_SCOPE_AGENT); }
__device__ __forceinline__ unsigned xb_xcc_id() { return (unsigned)__builtin_amdgcn_s_getreg((3 << 11) | 20) & 0xFu; }
#define XB_SPIN(cond, bar) do { unsigned _sp = 0; while (cond) { __builtin_amdgcn_s_sleep(1); \
    if ((++_sp & 255u) == 0u) { if (xb_ld(&(bar)[XB_TMO])) break; if (_sp > XB_SPIN_CAP) { atomicAdd(&(bar)[XB_TMO], 1u); break; } } } } while (0)

struct XcdBarrier {
    unsigned* bar; unsigned x;
    volatile LAS unsigned* st;
};

__device__ __forceinline__ XcdBarrier xcd_barrier_post(unsigned* bar, volatile LAS unsigned* st, bool t0) {
    XcdBarrier b; b.bar = bar; b.x = xb_xcc_id(); b.st = st;
    if (t0) (void)xb_add(&bar[XB_XCNT(b.x)], 1u);
    return b;
}
__device__ __forceinline__ void xcd_barrier_complete(unsigned* bar, unsigned x, unsigned& nloc, unsigned& nx) {
    const unsigned G = gridDim.x * gridDim.y * gridDim.z;
    unsigned sum, cnt, mine, sp = 0u;
    for (;;) {
        sum = 0u; cnt = 0u; mine = 0u;
#pragma unroll
        for (unsigned j = 0; j < 16; ++j) { const unsigned c = xb_ld(&bar[XB_XCNT(j)]); sum += c; cnt += (c > 0u) ? 1u : 0u; mine = (j == x) ? c : mine; }
        if (sum == G) break;
        __builtin_amdgcn_s_sleep(1);
        if ((++sp & 255u) == 0u) { if (xb_ld(&bar[XB_TMO])) break; if (sp > XB_SPIN_CAP) { atomicAdd(&bar[XB_TMO], 1u); break; } }
    }
    nloc = mine > 0u ? mine : 1u; nx = cnt > 0u ? cnt : 1u;
}

__device__ __forceinline__ void xcd_barrier(const XcdBarrier& b, bool t0) {
    asm volatile("s_waitcnt vmcnt(0)" ::: "memory");
    __syncthreads();
    if (t0) {
        unsigned* bar = b.bar;
        __builtin_amdgcn_s_waitcnt(0);
        unsigned nloc = b.st[0], nx = b.st[1];
        if (nloc == 0u) { xcd_barrier_complete(bar, b.x, nloc, nx); b.st[0] = nloc; b.st[1] = nx; }
        const unsigned old = xb_add(&bar[XB_XSUB(b.x)], 1u);
        const unsigned gen = old / nloc;
        if (old + 1u == (gen + 1u) * nloc) {
            __builtin_amdgcn_fence(__ATOMIC_RELEASE, "agent");
            asm volatile("s_waitcnt vmcnt(0)" ::: "memory");
            const unsigned og = xb_add(&bar[XB_TOP], 1u);
            const unsigned tg = og / nx;
            if (og + 1u == (tg + 1u) * nx) xb_add(&bar[XB_TOPGEN], 1u);
            else XB_SPIN(xb_ld(&bar[XB_TOPGEN]) == tg, bar);
            __builtin_amdgcn_fence(__ATOMIC_ACQUIRE, "agent");
            xb_add(&bar[XB_XGEN(b.x)], 1u);
            asm volatile("s_waitcnt vmcnt(0)" ::: "memory");
        } else {
            XB_SPIN(xb_ld(&bar[XB_XGEN(b.x)]) == gen, bar);
            __builtin_amdgcn_fence(__ATOMIC_ACQUIRE, "agent");
            asm volatile("s_waitcnt vmcnt(0)" ::: "memory");
        }
    }
    __syncthreads();
}

__device__ __forceinline__ void grid_barrier(unsigned char* ws, unsigned char* lds, int wave) {
    XcdBarrier b; b.bar = (unsigned*)(ws + WS_CTL); b.x = xb_xcc_id(); b.st = (volatile LAS unsigned*)((LAS unsigned char*)lds + LDS_BAR_OFF);
    xcd_barrier(b, wave == 0 && lane_id_now() == 0);
}

typedef short bf16x8 __attribute__((ext_vector_type(8)));
typedef float f32x16 __attribute__((ext_vector_type(16)));
typedef short v4i16_t __attribute__((ext_vector_type(4)));
typedef unsigned u32x2 __attribute__((ext_vector_type(2)));
typedef float f32x2_t __attribute__((ext_vector_type(2)));
typedef __bf16 bf16x2_t __attribute__((ext_vector_type(2)));
constexpr float LOG2E = 1.4426950408889634f;
constexpr float C2 = 0.125f * LOG2E;
__device__ __forceinline__ unsigned cvtpk(float lo, float hi) { f32x2_t v = {lo, hi}; bf16x2_t b = __builtin_convertvector(v, bf16x2_t); return __builtin_bit_cast(unsigned, b); }
__device__ __forceinline__ v4i16_t trread(const LAS unsigned char* p) { return __builtin_amdgcn_ds_read_tr16_b64_v4i16((LAS v4i16_t*)p); }
__device__ __forceinline__ bf16x8 mk8(v4i16_t lo, v4i16_t hi) { return (bf16x8){lo[0], lo[1], lo[2], lo[3], hi[0], hi[1], hi[2], hi[3]}; }
__device__ __forceinline__ float swapmax(float v) { auto rr = __builtin_amdgcn_permlane32_swap(__float_as_uint(v), __float_as_uint(v), false, false); return fmaxf(__uint_as_float(rr[0]), __uint_as_float(rr[1])); }
__device__ __forceinline__ float swapsum(float v) { auto rr = __builtin_amdgcn_permlane32_swap(__float_as_uint(v), __float_as_uint(v), false, false); return __uint_as_float(rr[0]) + __uint_as_float(rr[1]); }
#define MFMA32(a, b, c) __builtin_amdgcn_mfma_f32_32x32x16_bf16((a), (b), (c), 0, 0, 0)
#define F16Z (f32x16){0.f,0.f,0.f,0.f,0.f,0.f,0.f,0.f,0.f,0.f,0.f,0.f,0.f,0.f,0.f,0.f}

constexpr int A_K = 0, A_V = 49152, A_T = 98304, A_S = 106496, A_SP = 4608;
__device__ __forceinline__ void attn_unit(const Ctx& Fin, int l, int c, int kvh, LAS unsigned char* L) {
    const Ctx F = fresh(Fin);
    const int tid = F.tid, lane = F.lane, wave = F.wave, r32 = lane & 31, hi = lane >> 5;
    const int n = c % CPS; const long row0 = (long)c * CHUNK;
    const bf16* H = F.H();
#pragma unroll 2
    for (int idx = tid; idx < 3072; idx += NT) {
        const int r = idx >> 3, ch = idx & 7, pos = n * CHUNK - CHUNK + r; v4u kk = {0u, 0u, 0u, 0u}, vv = {0u, 0u, 0u, 0u};
        if (pos >= 0 && pos < SEQ) { const bf16* hr = H + (size_t)(row0 - CHUNK + r) * DIN + kvh * 64 + ch * 8; kk = *(const v4u*)(hr + C_K); vv = *(const v4u*)(hr + C_V); }
        *(LAS v4u*)(L + A_K + r * 128 + ((ch ^ ((r >> 1) & 7)) << 4)) = kk;
        *(LAS v4u*)(L + A_V + ((r >> 3) * 2 + (ch >> 2)) * 512 + (r & 7) * 64 + (ch & 3) * 16) = vv;
    }
    LAS float* tab = (LAS float*)(L + A_T);
    for (int idx = tid; idx < 2048; idx += NT) { const int g = idx >> 9, rel = (idx & 511) - 255;
        tab[idx] = (rel >= -128 && rel <= 128) ? F.BIAS()[(kvh * 4 + g) * 257 + rel + 128] * LOG2E : -INFINITY; }
    __syncthreads();
    const int g = wave >> 1, hq = kvh * 4 + g;
    const float sink2 = F.P(P_SINK)[l * 8 + hq] * LOG2E;
    LAS unsigned char* stg = L + A_S + wave * A_SP;
    int koff[4];
#pragma unroll
    for (int d0 = 0; d0 < 4; ++d0) koff[d0] = r32 * 128 + (((2 * d0 + hi) ^ ((r32 >> 1) & 7)) << 4);
    const int i16 = lane & 15, g16 = lane >> 4;
    const int vbase = (4 * hi + (i16 >> 2)) * 64 + 32 * (g16 & 1) + 8 * (i16 & 3);
    const LAS float* tg = tab + g * 512 + 127 - r32 + 4 * hi;
#pragma unroll 1
    for (int sb = 0; sb < 2; ++sb) {
        const int j = 2 * (wave & 1) + sb, q0 = 32 * j;
        int tlo = j < 2 ? 0 : 1, thi = j < 2 ? 5 : 6; if (n == 0) tlo = 2; if (n == CPS - 1) thi = 4;
        bf16x8 qf[4]; const bf16* qp = H + (size_t)(row0 + q0 + r32) * DIN + C_Q + hq * 64 + 8 * hi;
#pragma unroll
        for (int d0 = 0; d0 < 4; ++d0) qf[d0] = *(const bf16x8*)(qp + 16 * d0);
        f32x16 o0 = F16Z, o1 = F16Z; float m = sink2, lsum = hi ? 0.f : 1.f;
#pragma unroll 1
        for (int t = tlo; t < thi; ++t) {
            const LAS unsigned char* kp = L + A_K + t * (64 * 128);
            f32x16 p0 = F16Z, p1 = F16Z;
#pragma unroll
            for (int d0 = 0; d0 < 4; ++d0) { const bf16x8 k0 = *(const LAS bf16x8*)(kp + koff[d0]), k1 = *(const LAS bf16x8*)(kp + 32 * 128 + koff[d0]);
                p0 = MFMA32(k0, qf[d0], p0); p1 = MFMA32(k1, qf[d0], p1); }
            const LAS float* tb = tg + t * 64 - q0;
            float mx = -INFINITY;
#pragma unroll
            for (int r = 0; r < 16; ++r) { const int cr = (r & 3) + 8 * (r >> 2); p0[r] = fmaf(p0[r], C2, tb[cr]); p1[r] = fmaf(p1[r], C2, tb[cr + 32]); mx = fmaxf(mx, fmaxf(p0[r], p1[r])); }
            mx = swapmax(mx);
            const float mn = fmaxf(m, mx), alpha = __builtin_amdgcn_exp2f(m - mn); m = mn;
            float rs = 0.f;
#pragma unroll
            for (int r = 0; r < 16; ++r) { p0[r] = __builtin_amdgcn_exp2f(p0[r] - mn); p1[r] = __builtin_amdgcn_exp2f(p1[r] - mn); rs += p0[r] + p1[r]; }
            lsum = lsum * alpha + rs;
#pragma unroll
            for (int r = 0; r < 16; ++r) { o0[r] *= alpha; o1[r] *= alpha; }
            const LAS unsigned char* vp = L + A_V + vbase + t * (16 * 512);
#pragma unroll
            for (int s = 0; s < 2; ++s) {
                v4u w; w.x = cvtpk(p0[8 * s + 0], p0[8 * s + 1]); w.y = cvtpk(p0[8 * s + 2], p0[8 * s + 3]); w.z = cvtpk(p0[8 * s + 4], p0[8 * s + 5]); w.w = cvtpk(p0[8 * s + 6], p0[8 * s + 7]);
                const bf16x8 pf = __builtin_bit_cast(bf16x8, w); const int sub = 2 * s;
                o0 = MFMA32(mk8(trread(vp + ((sub + 0) * 2 + 0) * 512), trread(vp + ((sub + 1) * 2 + 0) * 512)), pf, o0);
                o1 = MFMA32(mk8(trread(vp + ((sub + 0) * 2 + 1) * 512), trread(vp + ((sub + 1) * 2 + 1) * 512)), pf, o1);
            }
#pragma unroll
            for (int s = 0; s < 2; ++s) {
                v4u w; w.x = cvtpk(p1[8 * s + 0], p1[8 * s + 1]); w.y = cvtpk(p1[8 * s + 2], p1[8 * s + 3]); w.z = cvtpk(p1[8 * s + 4], p1[8 * s + 5]); w.w = cvtpk(p1[8 * s + 6], p1[8 * s + 7]);
                const bf16x8 pf = __builtin_bit_cast(bf16x8, w); const int sub = 4 + 2 * s;
                o0 = MFMA32(mk8(trread(vp + ((sub + 0) * 2 + 0) * 512), trread(vp + ((sub + 1) * 2 + 0) * 512)), pf, o0);
                o1 = MFMA32(mk8(trread(vp + ((sub + 0) * 2 + 1) * 512), trread(vp + ((sub + 1) * 2 + 1) * 512)), pf, o1);
            }
        }
        lsum = swapsum(lsum); const float inv = 1.f / lsum;
#pragma unroll
        for (int i = 0; i < 4; ++i) { const int id = lane + 64 * i, row = id >> 3, ch = id & 7;
            *(LAS v4u*)(stg + row * 144 + ch * 16) = *(const v4u*)(H + (size_t)(row0 + q0 + row) * DIN + C_CG + hq * 64 + ch * 8); }
#pragma unroll
        for (int a = 0; a < 4; ++a) {
            { LAS u32x2* sp = (LAS u32x2*)(stg + r32 * 144 + (8 * a + 4 * hi) * 2); const u32x2 gw = *sp; u32x2 ow;
              ow.x = cvtpk(o0[4 * a + 0] * inv * silu_f(bflo(gw.x)), o0[4 * a + 1] * inv * silu_f(bfhi(gw.x))); ow.y = cvtpk(o0[4 * a + 2] * inv * silu_f(bflo(gw.y)), o0[4 * a + 3] * inv * silu_f(bfhi(gw.y))); *sp = ow; }
            { LAS u32x2* sp = (LAS u32x2*)(stg + r32 * 144 + (32 + 8 * a + 4 * hi) * 2); const u32x2 gw = *sp; u32x2 ow;
              ow.x = cvtpk(o1[4 * a + 0] * inv * silu_f(bflo(gw.x)), o1[4 * a + 1] * inv * silu_f(bfhi(gw.x))); ow.y = cvtpk(o1[4 * a + 2] * inv * silu_f(bflo(gw.y)), o1[4 * a + 3] * inv * silu_f(bfhi(gw.y))); *sp = ow; }
        }
#pragma unroll
        for (int i = 0; i < 4; ++i) { const int id = lane + 64 * i, row = id >> 3, ch = id & 7;
            *(v4u*)(F.MIX() + (size_t)(row0 + q0 + row) * DM + 512 + hq * 64 + ch * 8) = *(const LAS v4u*)(stg + row * 144 + ch * 16); }
    }
    __syncthreads();
}

constexpr int MA_VN = 0, MA_S = 65536, MA_SP = 9216;
__device__ __forceinline__ void mixA_unit(const Ctx& Fin, int l, int c, LAS unsigned char* L) {
    const Ctx F = fresh(Fin);
    const int lane = F.lane, wave = F.wave, r32 = lane & 31, hi = lane >> 5;
    const long row0 = (long)c * CHUNK; const bf16* H = F.H();
    {   const f32x4 gg = *(const f32x4*)(F.P(P_GMLP_G) + l * 256 + 4 * lane), bb = *(const f32x4*)(F.P(P_GMLP_B) + l * 256 + 4 * lane);
#pragma unroll 4
        for (int tt = 0; tt < 16; ++tt) { const int j = wave * 16 + tt;
            const u32x2 w = *(const u32x2*)(H + (size_t)(row0 + j) * DIN + C_AV + 4 * lane);
            float v0 = gelu_f(bflo(w.x)), v1 = gelu_f(bfhi(w.x)), v2 = gelu_f(bflo(w.y)), v3 = gelu_f(bfhi(w.y));
            const float mean = wave_sum((v0 + v1) + (v2 + v3)) * (1.f / 256.f); v0 -= mean; v1 -= mean; v2 -= mean; v3 -= mean;
            const float rstd = 1.f / sqrtf(wave_sum((v0 * v0 + v1 * v1) + (v2 * v2 + v3 * v3)) * (1.f / 256.f) + LN_EPS);
            u32x2 o; o.x = cvtpk(v0 * rstd * gg.x + bb.x, v1 * rstd * gg.y + bb.y); o.y = cvtpk(v2 * rstd * gg.z + bb.z, v3 * rstd * gg.w + bb.w);
            const int col = 4 * lane;
            *(LAS u32x2*)(L + MA_VN + ((j >> 3) * 8 + (col >> 5)) * 512 + (j & 7) * 64 + (col & 31) * 2) = o; } }
    __syncthreads();
    const int i16 = lane & 15, g16 = lane >> 4;
    const int abase = hi * (8 * 512) + (i16 >> 2) * 64 + 32 * (g16 & 1) + 8 * (i16 & 3);
    LAS unsigned char* stg = L + MA_S + wave * MA_SP;
    const bf16* WS = (const bf16*)(F.ws + WS_WSPB);
#pragma unroll 1
    for (int uu = 0; uu < 2; ++uu) {
        const int combo = wave * 2 + uu, h = combo >> 2, ib = combo & 3;
        bf16x8 wf[8]; const bf16* wp = WS + ((size_t)(l * 4 + h) * 128 + 32 * ib + r32) * 128 + 8 * hi;
#pragma unroll
        for (int s = 0; s < 8; ++s) wf[s] = *(const bf16x8*)(wp + 16 * s);
        f32x16 d0 = F16Z, d1 = F16Z;
        const LAS unsigned char* ap = L + MA_VN + abase + (2 * h) * 512;
#pragma unroll
        for (int s = 0; s < 8; ++s) {
            d0 = MFMA32(mk8(trread(ap + (16 * s + 0) * 512), trread(ap + (16 * s + 0) * 512 + 256)), wf[s], d0);
            d1 = MFMA32(mk8(trread(ap + (16 * s + 1) * 512), trread(ap + (16 * s + 1) * 512 + 256)), wf[s], d1);
        }
        const float bs = F.P(P_BSP)[(l * 4 + h) * 128 + 32 * ib + r32];
#pragma unroll
        for (int i = 0; i < 4; ++i) { const int id = lane + 64 * i, row = id >> 3, ch = id & 7; const bf16* hr = H + (size_t)(row0 + 32 * ib + row) * DIN + h * 64 + ch * 8;
            *(LAS v4u*)(stg + row * 144 + ch * 16) = *(const v4u*)(hr + C_AU); *(LAS v4u*)(stg + 4608 + row * 144 + ch * 16) = *(const v4u*)(hr + C_AG); }
#pragma unroll
        for (int a = 0; a < 4; ++a) {
            { LAS u32x2* sp = (LAS u32x2*)(stg + r32 * 144 + (8 * a + 4 * hi) * 2); const u32x2 uw = *sp, gw = *(LAS u32x2*)((LAS unsigned char*)sp + 4608); u32x2 ow;
              ow.x = cvtpk((d0[4 * a + 0] + bs) * gelu_f(bflo(uw.x)) * silu_f(bflo(gw.x)), (d0[4 * a + 1] + bs) * gelu_f(bfhi(uw.x)) * silu_f(bfhi(gw.x)));
              ow.y = cvtpk((d0[4 * a + 2] + bs) * gelu_f(bflo(uw.y)) * silu_f(bflo(gw.y)), (d0[4 * a + 3] + bs) * gelu_f(bfhi(uw.y)) * silu_f(bfhi(gw.y))); *sp = ow; }
            { LAS u32x2* sp = (LAS u32x2*)(stg + r32 * 144 + (32 + 8 * a + 4 * hi) * 2); const u32x2 uw = *sp, gw = *(LAS u32x2*)((LAS unsigned char*)sp + 4608); u32x2 ow;
              ow.x = cvtpk((d1[4 * a + 0] + bs) * gelu_f(bflo(uw.x)) * silu_f(bflo(gw.x)), (d1[4 * a + 1] + bs) * gelu_f(bfhi(uw.x)) * silu_f(bfhi(gw.x)));
              ow.y = cvtpk((d1[4 * a + 2] + bs) * gelu_f(bflo(uw.y)) * silu_f(bflo(gw.y)), (d1[4 * a + 3] + bs) * gelu_f(bfhi(uw.y)) * silu_f(bfhi(gw.y))); *sp = ow; }
        }
#pragma unroll
        for (int i = 0; i < 4; ++i) { const int id = lane + 64 * i, row = id >> 3, ch = id & 7;
            *(v4u*)(F.MIX() + (size_t)(row0 + 32 * ib + row) * DM + h * 64 + ch * 8) = *(const LAS v4u*)(stg + row * 144 + ch * 16); }
    }
    __syncthreads();
}

constexpr int MB_Y = 0, MB_C = 81920;
__device__ __forceinline__ void mixB_unit(const Ctx& Fin, int l, int c, LAS unsigned char* L) {
    const Ctx F = fresh(Fin);
    const int tid = F.tid, lane = F.lane, wave = F.wave;
    const int n = c % CPS; const long row0 = (long)c * CHUNK; const bf16* H = F.H();
#pragma unroll 2
    for (int rr = wave; rr < 158; rr += NWAVES) { const int pos = n * CHUNK - 15 + rr; u32x2 o = {0u, 0u};
        if (pos >= 0 && pos < SEQ) { const bf16* hr = H + (size_t)(row0 - 15 + rr) * DIN + 4 * lane; const u32x2 a = *(const u32x2*)(hr + C_BA), b = *(const u32x2*)(hr + C_BB);
            o.x = cvtpk(bflo(a.x) * sigmoid_f(bflo(b.x)), bfhi(a.x) * sigmoid_f(bfhi(b.x))); o.y = cvtpk(bflo(a.y) * sigmoid_f(bflo(b.y)), bfhi(a.y) * sigmoid_f(bfhi(b.y))); }
        *(LAS u32x2*)(L + MB_Y + rr * 512 + lane * 8) = o; }
    __syncthreads();
    const int ch = tid & 255, half = tid >> 8;
    float w[31]; { const float* cw = F.P(P_CONVW) + (size_t)l * 31 * 256 + ch;
#pragma unroll
        for (int k = 0; k < 31; ++k) w[k] = cw[k * 256]; }
    const float cb = F.P(P_CONVB)[l * 256 + ch];
    const LAS bf16* ys = (const LAS bf16*)(L + MB_Y) + ch;
    LAS float* cs = (LAS float*)(L + MB_C);
    const f32x4 gg = *(const f32x4*)(F.P(P_CONVG) + l * 256 + 4 * lane), bb = *(const f32x4*)(F.P(P_CONVBB) + l * 256 + 4 * lane);
#pragma unroll 1
    for (int blk = 0; blk < 4; ++blk) {
        const int t0 = half * 64 + blk * 16;
        float acc[16];
#pragma unroll
        for (int t = 0; t < 16; ++t) acc[t] = cb;
#pragma unroll
        for (int r = 0; r < 46; ++r) { const float yv = bf2f(ys[(t0 + r) * 256]);
#pragma unroll
            for (int t = 0; t < 16; ++t) { const int k = r - t; if (k >= 0 && k <= 30) acc[t] = fmaf(w[k], yv, acc[t]); } }
#pragma unroll
        for (int t = 0; t < 16; ++t) cs[(half * 16 + t) * 256 + ch] = acc[t];
        __syncthreads();
#pragma unroll
        for (int i = 0; i < 4; ++i) { const int srow = wave * 4 + i, tok = (srow >> 4) * 64 + blk * 16 + (srow & 15);
            f32x4 v = *(const LAS f32x4*)(cs + srow * 256 + 4 * lane);
            const float mean = wave_sum((v.x + v.y) + (v.z + v.w)) * (1.f / 256.f); v = v - mean;
            const float rstd = 1.f / sqrtf(wave_sum((v.x * v.x + v.y * v.y) + (v.z * v.z + v.w * v.w)) * (1.f / 256.f) + LN_EPS);
            const f32x4 y = v * rstd * gg + bb;
            const u32x2 gw = *(const u32x2*)(H + (size_t)(row0 + tok) * DIN + C_BG + 4 * lane); u32x2 o;
            o.x = cvtpk(silu_f(y.x) * silu_f(bflo(gw.x)), silu_f(y.y) * silu_f(bfhi(gw.x))); o.y = cvtpk(silu_f(y.z) * silu_f(bflo(gw.y)), silu_f(y.w) * silu_f(bfhi(gw.y)));
            *(u32x2*)(F.MIX() + (size_t)(row0 + tok) * DM + 256 + 4 * lane) = o; }
        __syncthreads();
    }
}
#ifndef FAST_ATTN
#define FAST_ATTN 1
#endif
#ifndef FAST_A
#define FAST_A 1
#endif
#ifndef FAST_B
#define FAST_B 1
#endif
#ifndef REP_PRO
#define REP_PRO 0
#endif
#ifndef REP_G1
#define REP_G1 0
#endif
#ifndef REP_MIX
#define REP_MIX 0
#endif
#ifndef REP_G2
#define REP_G2 0
#endif
#ifndef REP_LN
#define REP_LN 0
#endif
#ifndef REP_SYNC
#define REP_SYNC 0
#endif
__global__ void __launch_bounds__(NT, 2) fwd(Args args) {
    extern __shared__ __attribute__((aligned(16))) unsigned char lds[];
    cg::grid_group grid = cg::this_grid();
    Ctx F;
    F.wave = __builtin_amdgcn_readfirstlane(threadIdx.x >> 6); F.lane = 0; F.tid = 0; F.G = gridDim.x; F.bid = blockIdx.x;
    F.ws = args.ws; F.out = args.out;
    {   const bool t0 = F.wave == 0 && lane_id_now() == 0;
        if (t0) { ((volatile LAS unsigned*)((LAS unsigned char*)lds + LDS_BAR_OFF))[0] = 0u; ((volatile LAS unsigned*)((LAS unsigned char*)lds + LDS_BAR_OFF))[1] = 0u; }
        __syncthreads();
        (void)xcd_barrier_post((unsigned*)(F.ws + WS_CTL), (volatile LAS unsigned*)((LAS unsigned char*)lds + LDS_BAR_OFF), t0);
    }
#define SEAM() grid_barrier(F.ws, lds, F.wave)

#pragma unroll 1
    for (int rep = 0; rep <= REP_PRO; ++rep) { const Ctx P = fresh(F); prologue(P, args, lds); __syncthreads(); }
    grid.sync();
#pragma unroll 1
    for (int rep = 0; rep < REP_SYNC; ++rep) SEAM();
#pragma unroll 1
    for (int l = 0; l < DEPTH; ++l) {
        {
            pg8::Gemm g{F.XN(), F.WIN() + (size_t)l * DIN * DM, M, DIN, DM}; pg8::StaticOrder S; S.init(M, DIN, F.G, F.bid);
            pg8::EpiBf16<0> E{F.H(), DIN, nullptr, 0, 0, 1.f};
#pragma unroll 1
            for (int rep = 0; rep <= REP_G1; ++rep)
            pg8::gemm_phase<pg8::EpiBf16<0>, pg8::StaticOrder, true, true>((PG8_LAS unsigned char*)lds, g, S, E, F.wave);
        }
        SEAM();
#pragma unroll 1
        for (int rep = 0; rep <= REP_MIX; ++rep)
        {   const Ctx P = fresh(F);
            for (int c = P.bid; c < NCHUNK; c += P.G) {
#if FAST_ATTN
#pragma unroll 1
                for (int kvh = 0; kvh < 2; ++kvh) attn_unit(P, l, c, kvh, (LAS unsigned char*)lds);
#else
                naive_attn(P, l, c, 0, lds); naive_attn(P, l, c, 1, lds);
#endif
#if FAST_A
                mixA_unit(P, l, c, (LAS unsigned char*)lds);
#else
                naive_mixA(P, l, c, lds);
#endif
#if FAST_B
                mixB_unit(P, l, c, (LAS unsigned char*)lds);
#else
                naive_mixB(P, l, c, lds);
#endif
            } }
        SEAM();
        {
            pg8::Gemm g{F.MIX(), F.WOUT() + (size_t)l * DM * DM, M, DM, DM}; pg8::StaticOrder S; S.init(M, DM, F.G, F.bid);
#pragma unroll 1
            for (int rep = REP_G2; rep >= 0; --rep) {
            pg8::EpiResF32 E{F.out, rep ? (float*)F.H() : F.out, DM, ALPHA};
            pg8::gemm_phase<pg8::EpiResF32, pg8::StaticOrder, true, true>((PG8_LAS unsigned char*)lds, g, S, E, F.wave); }
        }
        SEAM();
#pragma unroll 1
        for (int rep = REP_LN; rep >= 0; --rep) { const Ctx P = fresh(F); post_ln(P, l, rep ? (float*)P.H() : P.out, rep ? P.MIX() : P.XN()); }
        if (l + 1 < DEPTH) SEAM();
    }
}

extern "C" void kernel_launch(void* const* d_in, const int* in_sizes, int n_in, void* d_out, int out_size, void* d_ws, size_t ws_size, hipStream_t stream) {
    static int grid = 0;
    if (grid == 0) {
        if (n_in != 17 || out_size != M * DM || ws_size < WS_END) { fprintf(stderr, "kernel_launch: unexpected shapes n_in %d out %d ws %zu\n", n_in, out_size, ws_size); grid = -1; return; }
        int dev = 0, cus = 0, per_cu = 0;
        (void)hipGetDevice(&dev);
        (void)hipDeviceGetAttribute(&cus, hipDeviceAttributeMultiprocessorCount, dev);
        (void)hipFuncSetAttribute((const void*)fwd, hipFuncAttributeMaxDynamicSharedMemorySize, LDS_BYTES);
        (void)hipOccupancyMaxActiveBlocksPerMultiprocessor(&per_cu, (const void*)fwd, NT, LDS_BYTES);
        if (per_cu < 1) fprintf(stderr, "kernel_launch: occupancy query reports %d blocks per CU\n", per_cu);
        grid = cus;
    }
    if (grid < 0) return;
    if (hipMemsetAsync((char*)d_ws + WS_CTL, 0, CTL_BYTES, stream) != hipSuccess) { fprintf(stderr, "kernel_launch: hipMemsetAsync failed\n"); return; }
    Args a{};
    for (int i = 0; i < 17; ++i) a.in[i] = (const float*)d_in[i];
    a.out = (float*)d_out; a.ws = (unsigned char*)d_ws;
    void* kargs[] = {&a};
    hipError_t e = hipLaunchCooperativeKernel((void*)fwd, dim3(grid), dim3(NT), kargs, LDS_BYTES, stream);
    if (e != hipSuccess) fprintf(stderr, "cooperative launch failed: %s (grid %d)\n", hipGetErrorString(e), grid);
}
```
